# Optimizing an MI355X kernel written in HIP

```python
import jax, jax.numpy as jnp
from jax import lax
import numpy as np

D_MODEL = 2048
BATCH = 4
SEQ = 2048
DEPTH = 1
DEC_BATCH = 128
DEC_SEQ = 4
PAST_LEN = 16384
PAGE_SIZE = 128

GLA_HEADS = 4
GLA_DK = D_MODEL // 2 // GLA_HEADS
GLA_DV = D_MODEL // GLA_HEADS
GLA_RANK = 16
GLA_TAU = 16.0
GLA_CHUNK = 16
RET_HEADS = 8
RET_DK = D_MODEL // 2 // RET_HEADS
RET_DV = D_MODEL // RET_HEADS
RET_CHUNK = 64
ROPE_BASE = 10000.0
LN_EPS = 1e-5
HEAD_NORM_EPS = 1e-6
DEEPNORM_ALPHA = (2.0 * DEPTH) ** 0.25
DEEPNORM_BETA = (8.0 * DEPTH) ** -0.25

QK_A = GLA_HEADS * GLA_DK
V_A = GLA_HEADS * GLA_DV
QK_B = RET_HEADS * RET_DK
V_B = RET_HEADS * RET_DV
SPLITS = (QK_A, QK_A, V_A, V_A, GLA_RANK, QK_B, QK_B, V_B, V_B, D_MODEL, D_MODEL)
D_IN = sum(SPLITS)

kernel_name = "gla_retnet_parallel_gated_deepnorm_step"


def _split_cols(h):
    idx, acc = [], 0
    for s in SPLITS[:-1]:
        acc += s
        idx.append(acc)
    return jnp.split(h, idx, axis=-1)


def _pad_time(a, n_pad):
    if n_pad == 0:
        return a
    return jnp.pad(a, [(0, 0), (0, n_pad)] + [(0, 0)] * (a.ndim - 2))


def _to_chunks(t, n, c):
    B = t.shape[0]
    return t.reshape(B, n, c, *t.shape[2:]).transpose(1, 0, 3, 2, *range(4, t.ndim + 1))


def gla_chunked(q, k, v, log_a, s0):
    B, L, H, _ = q.shape
    c = min(GLA_CHUNK, L)
    n = -(-L // c)
    pad = n * c - L
    f32 = jnp.float32
    qc, kc, vc, ac = [_to_chunks(_pad_time(t.astype(f32), pad), n, c) for t in (q, k, v, log_a)]
    mask = jnp.tril(jnp.ones((c, c), dtype=bool))

    def step(S, inp):
        qi, ki, vi, ai = inp
        b = jnp.cumsum(ai, axis=2)
        b_last = b[:, :, -1, :]
        o_inter = jnp.einsum('bhtk,bhkv->bhtv', qi * jnp.exp(b), S)
        rel = b[:, :, :, None, :] - b[:, :, None, :, :]
        rel = jnp.exp(jnp.where(mask[:, :, None], rel, -jnp.inf))
        scores = jnp.einsum('bhtk,bhsk,bhtsk->bhts', qi, ki, rel)
        o_intra = jnp.einsum('bhts,bhsv->bhtv', scores, vi)
        S_new = jnp.exp(b_last)[..., None] * S + jnp.einsum(
            'bhsk,bhsv->bhkv', ki * jnp.exp(b_last[:, :, None, :] - b), vi)
        return S_new, o_inter + o_intra

    S, o = lax.scan(step, s0.astype(f32), (qc, kc, vc, ac))
    o = o.transpose(1, 0, 3, 2, 4).reshape(B, n * c, H, -1)[:, :L]
    return o, S.astype(s0.dtype)


def retention_chunked(q, k, v, log_g, s0):
    B, L, H, _ = q.shape
    c = min(RET_CHUNK, L)
    n = -(-L // c)
    pad = n * c - L
    f32 = jnp.float32
    qc, kc, vc = [_to_chunks(_pad_time(t.astype(f32), pad), n, c) for t in (q, k, v)]
    gc = _pad_time(log_g.astype(f32), pad).reshape(B, n, c, H).transpose(1, 0, 3, 2)
    mask = jnp.tril(jnp.ones((c, c), dtype=bool))

    def step(S, inp):
        qi, ki, vi, gi = inp
        b = jnp.cumsum(gi, axis=-1)
        b_last = b[:, :, -1]
        o_inter = jnp.einsum('bhtk,bhkv->bhtv', qi * jnp.exp(b)[..., None], S)
        decay = jnp.exp(jnp.where(mask, b[:, :, :, None] - b[:, :, None, :], -jnp.inf))
        scores = jnp.einsum('bhtk,bhsk->bhts', qi, ki) * decay
        o_intra = jnp.einsum('bhts,bhsv->bhtv', scores, vi)
        S_new = jnp.exp(b_last)[..., None, None] * S + jnp.einsum(
            'bhsk,bhsv->bhkv', ki * jnp.exp(b_last[..., None] - b)[..., None], vi)
        return S_new, o_inter + o_intra

    S, o = lax.scan(step, s0.astype(f32), (qc, kc, vc, gc))
    o = o.transpose(1, 0, 3, 2, 4).reshape(B, n * c, H, -1)[:, :L]
    return o, S.astype(s0.dtype)


def _rotate(x, pos):
    f32 = jnp.float32
    inv = 1.0 / (ROPE_BASE ** jnp.linspace(0.0, 1.0, RET_DK // 2, dtype=f32))
    ang = pos.astype(f32)[:, None] * inv[None, :]
    sin = jnp.sin(ang)[None, :, None, :]
    cos = jnp.cos(ang)[None, :, None, :]
    xf = x.astype(f32)
    x1, x2 = xf[..., 0::2], xf[..., 1::2]
    return jnp.stack([x1 * cos - x2 * sin, x2 * cos + x1 * sin], axis=-1).reshape(x.shape)


def _ret_log_decay():
    return jnp.log(1.0 - 2.0 ** (-5.0 - jnp.arange(RET_HEADS, dtype=jnp.float32)))


def _rms_heads(o, w):
    o = o * lax.rsqrt(jnp.mean(o * o, axis=-1, keepdims=True) + HEAD_NORM_EPS) * w.astype(jnp.float32)
    return o.reshape(o.shape[0], o.shape[1], -1)


def _group_norm(o, w, b):
    mu = jnp.mean(o, axis=-1, keepdims=True)
    d = o - mu
    var = jnp.mean(d * d, axis=-1, keepdims=True)
    o = d * lax.rsqrt(var + HEAD_NORM_EPS)
    o = o * w.astype(jnp.float32).reshape(RET_HEADS, RET_DV) + b.astype(jnp.float32).reshape(RET_HEADS, RET_DV)
    return o.reshape(o.shape[0], o.shape[1], -1)


def _layer_norm(x, w, b):
    xf = x.astype(jnp.float32)
    mu = jnp.mean(xf, axis=-1, keepdims=True)
    d = xf - mu
    var = jnp.mean(d * d, axis=-1, keepdims=True)
    return d * lax.rsqrt(var + LN_EPS) * w.astype(jnp.float32) + b.astype(jnp.float32)


def hybrid_layer(x, pos, s_gla0, s_ret0, w_in, w_lr, b_lr, gla_norm_w, ret_norm_w, ret_norm_b, w_out, ln_w, ln_b):
    B, L, _ = x.shape
    f32 = jnp.float32
    h = jnp.einsum('bld,de->ble', x, w_in)
    qa, ka, va, za, lra, qb, kb, vb, zb, ga, gb = _split_cols(h)

    qa = qa.reshape(B, L, GLA_HEADS, GLA_DK) * (GLA_DK ** -0.5)
    ka = ka.reshape(B, L, GLA_HEADS, GLA_DK)
    va = va.reshape(B, L, GLA_HEADS, GLA_DV)
    gate_logit = (jnp.einsum('blr,rk->blk', lra, w_lr) + b_lr).astype(f32)
    log_a = (jax.nn.log_sigmoid(gate_logit) / GLA_TAU).reshape(B, L, GLA_HEADS, GLA_DK)
    o_a, s_gla = gla_chunked(qa, ka, va, log_a, s_gla0)
    o_a = _rms_heads(o_a, gla_norm_w) * jax.nn.silu(za.astype(f32))

    qb = _rotate(qb.reshape(B, L, RET_HEADS, RET_DK), pos)
    kb = _rotate(kb.reshape(B, L, RET_HEADS, RET_DK), pos) * (RET_DK ** -0.5)
    vb = vb.reshape(B, L, RET_HEADS, RET_DV)
    log_g = jnp.broadcast_to(_ret_log_decay(), (B, L, RET_HEADS))
    o_b, s_ret = retention_chunked(qb, kb, vb, log_g, s_ret0)
    o_b = _group_norm(o_b, ret_norm_w, ret_norm_b) * jax.nn.silu(zb.astype(f32))

    merged = jax.nn.sigmoid(ga.astype(f32)) * o_a + jax.nn.sigmoid(gb.astype(f32)) * o_b
    y = jnp.einsum('ble,ed->bld', merged.astype(x.dtype), w_out)
    x_new = _layer_norm(DEEPNORM_ALPHA * x + y, ln_w, ln_b)
    return x_new.astype(x.dtype), s_gla, s_ret


def setup_inputs(seed: int = 0) -> dict:
    key = jax.random.key(seed)
    ks = jax.random.split(key, 20)
    f32 = jnp.float32
    x_prompt = jax.random.normal(ks[0], (BATCH, SEQ, D_MODEL), f32)
    x_sample = jax.random.normal(ks[1], (DEC_BATCH, DEC_SEQ, D_MODEL), f32)
    state_gla = 0.5 * jax.random.normal(ks[2], (DEPTH, DEC_BATCH, GLA_HEADS, GLA_DK, GLA_DV), f32)
    state_ret = 0.5 * jax.random.normal(ks[3], (DEPTH, DEC_BATCH, RET_HEADS, RET_DK, RET_DV), f32)
    col_scale = []
    for i, s in enumerate(SPLITS):
        scale = DEEPNORM_BETA if i in (2, 7) else 1.0
        col_scale.append(jnp.full((s,), scale, f32))
    col_scale = jnp.concatenate(col_scale)
    w_in = jax.random.normal(ks[4], (DEPTH, D_MODEL, D_IN), f32) * (D_MODEL ** -0.5) * col_scale
    w_lr = jax.random.normal(ks[5], (DEPTH, GLA_RANK, QK_A), f32) * (GLA_RANK ** -0.5)
    b_lr = 1.0 + 0.5 * jax.random.normal(ks[6], (DEPTH, QK_A), f32)
    gla_norm_w = 1.0 + 0.02 * jax.random.normal(ks[7], (DEPTH, GLA_DV), f32)
    ret_norm_w = 1.0 + 0.02 * jax.random.normal(ks[8], (DEPTH, V_B), f32)
    ret_norm_b = 0.02 * jax.random.normal(ks[9], (DEPTH, V_B), f32)
    w_out = jax.random.normal(ks[10], (DEPTH, V_A, D_MODEL), f32) * (V_A ** -0.5) * DEEPNORM_BETA
    ln_w = 1.0 + 0.02 * jax.random.normal(ks[11], (DEPTH, D_MODEL), f32)
    ln_b = 0.02 * jax.random.normal(ks[12], (DEPTH, D_MODEL), f32)
    return {"x_prompt": x_prompt, "x_sample": x_sample, "state_gla": state_gla, "state_ret": state_ret,
            "w_in": w_in, "w_lr": w_lr, "b_lr": b_lr, "gla_norm_w": gla_norm_w,
            "ret_norm_w": ret_norm_w, "ret_norm_b": ret_norm_b, "w_out": w_out,
            "ln_w": ln_w, "ln_b": ln_b}


def reference(x_prompt, x_sample, state_gla, state_ret, w_in, w_lr, b_lr, gla_norm_w,
              ret_norm_w, ret_norm_b, w_out, ln_w, ln_b):
    pos_prompt = jnp.arange(x_prompt.shape[1], dtype=jnp.int32)
    pos_sample = PAST_LEN + jnp.arange(x_sample.shape[1], dtype=jnp.int32)
    hp, hs = x_prompt, x_sample
    gla_p, ret_p, gla_s, ret_s = [], [], [], []
    for l in range(DEPTH):
        params = (w_in[l], w_lr[l], b_lr[l], gla_norm_w[l], ret_norm_w[l], ret_norm_b[l],
                  w_out[l], ln_w[l], ln_b[l])
        zero_gla = jnp.zeros((hp.shape[0], GLA_HEADS, GLA_DK, GLA_DV), state_gla.dtype)
        zero_ret = jnp.zeros((hp.shape[0], RET_HEADS, RET_DK, RET_DV), state_ret.dtype)
        hp, sg_p, sr_p = hybrid_layer(hp, pos_prompt, zero_gla, zero_ret, *params)
        hs, sg_s, sr_s = hybrid_layer(hs, pos_sample, state_gla[l], state_ret[l], *params)
        gla_p.append(sg_p)
        ret_p.append(sr_p)
        gla_s.append(sg_s)
        ret_s.append(sr_s)
    new_gla_prompt = jnp.stack(gla_p)
    new_ret_prompt = jnp.stack(ret_p)
    new_gla_sample = jnp.stack(gla_s)
    new_ret_sample = jnp.stack(ret_s)
    return (hp, hs, new_gla_prompt, new_ret_prompt, new_gla_sample, new_ret_sample)
```

```cpp
#include <hip/hip_runtime.h>
#include <cstdio>
#include <cstdint>
#define MK_N_LAUNCHES 1
namespace pg8 {
#define PG8_LAS __attribute__((address_space(3)))
typedef unsigned short bf16_t;
typedef short bf16x8 __attribute__((ext_vector_type(8)));
typedef float f32x4 __attribute__((ext_vector_type(4)));
typedef unsigned u32x4 __attribute__((ext_vector_type(4)));
constexpr int BM = 256, BK = 64, HALF = 128, HTB = HALF * BK * 2  , STAGE_BYTES = 8 * HTB, NXCD = 8, WGM = 8;

__host__ __device__ __forceinline__ int lds_byte(int r, int c) { const int st = (r >> 4) * 2 + (c >> 5), rr = r & 15, cc = c & 31, ob = rr * 64 + cc * 2; return st * 1024 + (ob ^ (((ob >> 9) & 1) << 5)); }
__host__ __device__ __forceinline__ void stage_rc(int b, int& R, int& C) { const int st = b / 1024, sb = b % 1024, swz = sb ^ (((sb >> 9) & 1) << 5); R = (st >> 1) * 16 + swz / 64; C = (st & 1) * 32 + (swz % 64) / 2; }
__host__ __device__ __forceinline__ int perm32(int rho) { const int n = rho >> 4, i = rho & 15; return 8 * (i >> 2) + 4 * n + (i & 3); }

struct Unit { int pm, pn; };
struct Gemm { const bf16_t* A; const bf16_t* Bt; int M, N, K; };

struct StaticOrder {
    int nM, nN, nwg, G, c;
    __host__ __device__ void init(int M, int N, int G_, int c_) { nM = M / BM; nN = N / BM; nwg = nM * nN; G = G_; c = c_; }
    __host__ __device__ bool next(int i, Unit& u) const {
        const long L = (long)i * G + c; if (L >= nwg) return false;
        int wgid = (int)L; { const int q = nwg / NXCD, r = nwg % NXCD, xcd = wgid % NXCD, off = wgid / NXCD; wgid = (xcd < r ? xcd * (q + 1) : r * (q + 1) + (xcd - r) * q) + off; }
        const int nig = WGM * nN, gid = wgid / nig, fm = gid * WGM, gsz = (nM - fm) < WGM ? (nM - fm) : WGM;
        u.pm = fm + ((wgid % nig) % gsz); u.pn = (wgid % nig) / gsz; return true;
    }
    __device__ __forceinline__ void a_ready(const Unit&) const {}
    __device__ __forceinline__ void done(const Unit&) const {}
};

template <class Epi, class Sched, bool ALIGN_EPI = false, bool SP2 = false>
__device__ __forceinline__ void gemm_phase(PG8_LAS unsigned char* lds, const Gemm g, const Sched& S, const Epi& E) {
    const int tid = threadIdx.x, wid = __builtin_amdgcn_readfirstlane(tid >> 6), lane = tid & 63, wr = wid >> 2, wc = wid & 3, fr = lane & 15, fq = lane >> 4;
    const int K = g.K, nt = K / BK;
    unsigned voffA[2], voffB[2];
#pragma unroll
    for (int i = 0; i < 2; ++i) { int R, C; stage_rc(tid * 16 + i * 8192, R, C); const int Rb = Epi::PERM ? ((R & ~31) + perm32(R & 31)) : R;
        voffA[i] = (unsigned)(R * K + C) * 2u; voffB[i] = (unsigned)(Rb * K + C) * 2u; }
    const size_t kstep = (size_t)(BK * 2);
    const size_t hstep = (size_t)HALF * K * 2;
    const size_t tstep = 2 * hstep;
    const unsigned ldsw = (unsigned)wid * 1024u;
    const int aoff = lds_byte(wr * 64 + fr, fq * 8), boff = lds_byte(wc * 32 + fr, fq * 8);
#define PG8_SA(b, h) (((b) * 2 + (h)) * HTB)
#define PG8_SB(b, h) ((4 + (b) * 2 + (h)) * HTB)
#define PG8_STAGE(bufoff, gbase, voff) do { _Pragma("unroll") for (int _i = 0; _i < 2; ++_i) \
        __builtin_amdgcn_global_load_lds((const unsigned*)((const char*)(gbase) + (voff)[_i]), (PG8_LAS unsigned*)(lds + (bufoff) + ldsw + _i * 8192), 16, 0, 0); } while (0)
#define PG8_LDA(dst, b, h) do { _Pragma("unroll") for (int m = 0; m < 4; ++m) _Pragma("unroll") for (int k = 0; k < 2; ++k) dst[m][k] = *(const PG8_LAS bf16x8*)(lds + PG8_SA(b, h) + aoff + m * 2048 + k * 1024); } while (0)
#define PG8_LDB(dst, b, h) do { _Pragma("unroll") for (int n = 0; n < 2; ++n) _Pragma("unroll") for (int k = 0; k < 2; ++k) dst[n][k] = *(const PG8_LAS bf16x8*)(lds + PG8_SB(b, h) + boff + n * 2048 + k * 1024); } while (0)
#define PG8_MMA(ai, bj, At, Bt) do { __builtin_amdgcn_s_setprio(1); _Pragma("unroll") for (int m = 0; m < 4; ++m) _Pragma("unroll") for (int n = 0; n < 2; ++n) _Pragma("unroll") for (int k = 0; k < 2; ++k) \
        acc[ai][bj][m][n] = __builtin_amdgcn_mfma_f32_16x16x32_bf16(Bt[n][k], At[m][k], acc[ai][bj][m][n], 0, 0, 0); __builtin_amdgcn_s_setprio(0); } while (0)
#define PG8_WAIT_V(n) asm volatile("s_waitcnt vmcnt(" #n ")" ::: "memory")
#define PG8_WAIT_L(n) asm volatile("s_waitcnt lgkmcnt(" #n ")" ::: "memory")
#define PG8_BAR __builtin_amdgcn_s_barrier()
#define PG8_SCHED __builtin_amdgcn_sched_barrier(0)
    Unit cur, nxt; int ui = 0;
    if (!S.next(0, cur)) return;
    f32x4 acc[2][2][4][2];
#pragma unroll
    for (int a = 0; a < 2; ++a)
#pragma unroll
        for (int b = 0; b < 2; ++b)
#pragma unroll
            for (int m = 0; m < 4; ++m)
#pragma unroll
                for (int n = 0; n < 2; ++n) acc[a][b][m][n] = (f32x4){0.f, 0.f, 0.f, 0.f};
    bf16x8 At[4][2], B0[2][2], B1[2][2];
    const char* cA = (const char*)g.A + (size_t)cur.pm * tstep; const char* cB = (const char*)g.Bt + (size_t)cur.pn * tstep;
    S.a_ready(cur);
    if constexpr (SP2) {
        PG8_STAGE(PG8_SB(0, 0), cB, voffB); PG8_STAGE(PG8_SB(0, 1), cB + hstep, voffB); PG8_STAGE(PG8_SA(0, 0), cA, voffA); PG8_STAGE(PG8_SA(0, 1), cA + hstep, voffA);
        if (wr == 1) PG8_BAR;
        PG8_WAIT_V(2); PG8_BAR;
        PG8_STAGE(PG8_SB(1, 0), cB + kstep, voffB); PG8_STAGE(PG8_SA(1, 0), cA + kstep, voffA); PG8_STAGE(PG8_SB(1, 1), cB + hstep + kstep, voffB);
        PG8_WAIT_V(6); PG8_BAR;
    } else {
        PG8_STAGE(PG8_SB(0, 0), cB, voffB); PG8_STAGE(PG8_SA(0, 0), cA, voffA); PG8_STAGE(PG8_SB(0, 1), cB + hstep, voffB); PG8_STAGE(PG8_SA(0, 1), cA + hstep, voffA);
        if (wr == 1) PG8_BAR;
        PG8_WAIT_V(4); PG8_BAR;
        PG8_STAGE(PG8_SB(1, 0), cB + kstep, voffB); PG8_STAGE(PG8_SA(1, 0), cA + kstep, voffA); PG8_STAGE(PG8_SB(1, 1), cB + hstep + kstep, voffB);
        PG8_WAIT_V(6); PG8_BAR;
    }
    for (;;) {
        const bool has_next = S.next(ui + 1, nxt);
        const char* nA = has_next ? (const char*)g.A + (size_t)nxt.pm * tstep : cA; const char* nB = has_next ? (const char*)g.Bt + (size_t)nxt.pn * tstep : cB;
        for (int t = 0; t < nt; t += 2) {
            const bool last = (t == nt - 2);
            const char* a1 = cA + (size_t)(t + 1) * kstep;
            const char* a2 = last ? nA : cA + (size_t)(t + 2) * kstep; const char* b2 = last ? nB : cB + (size_t)(t + 2) * kstep;
            const char* a3 = a2 + kstep; const char* b3 = b2 + kstep;
            if (last && has_next) S.a_ready(nxt);
            if constexpr (SP2) {
            PG8_LDB(B0, 0, 0); PG8_LDB(B1, 0, 1); PG8_SCHED; PG8_LDA(At, 0, 0); PG8_STAGE(PG8_SA(1, 1), a1 + hstep, voffA);
            PG8_WAIT_V(8); PG8_WAIT_L(0); PG8_BAR; PG8_MMA(0, 0, At, B0); PG8_MMA(0, 1, At, B1); PG8_BAR; PG8_SCHED;
            PG8_LDA(At, 0, 1); PG8_STAGE(PG8_SB(0, 0), b2, voffB); PG8_STAGE(PG8_SB(0, 1), b2 + hstep, voffB); PG8_STAGE(PG8_SA(0, 0), a2, voffA);
            PG8_WAIT_V(8); PG8_WAIT_L(0); PG8_BAR; PG8_MMA(1, 0, At, B0); PG8_MMA(1, 1, At, B1); PG8_BAR; PG8_SCHED;
            PG8_LDB(B0, 1, 0); PG8_LDB(B1, 1, 1); PG8_SCHED; PG8_LDA(At, 1, 0); PG8_STAGE(PG8_SA(0, 1), a2 + hstep, voffA);
            PG8_WAIT_V(8); PG8_WAIT_L(0); PG8_BAR; PG8_MMA(0, 0, At, B0); PG8_MMA(0, 1, At, B1); PG8_BAR; PG8_SCHED;
            PG8_LDA(At, 1, 1); PG8_STAGE(PG8_SB(1, 0), b3, voffB); PG8_STAGE(PG8_SB(1, 1), b3 + hstep, voffB); PG8_STAGE(PG8_SA(1, 0), a3, voffA);
            PG8_WAIT_V(8); PG8_WAIT_L(0); PG8_BAR; PG8_MMA(1, 0, At, B0); PG8_MMA(1, 1, At, B1); PG8_BAR; PG8_SCHED;
            } else {
            PG8_LDB(B0, 0, 0); PG8_SCHED; PG8_LDA(At, 0, 0); PG8_STAGE(PG8_SA(1, 1), a1 + hstep, voffA);
            PG8_WAIT_L(8); PG8_BAR; PG8_WAIT_L(0); PG8_MMA(0, 0, At, B0); PG8_BAR; PG8_SCHED;
            PG8_LDB(B1, 0, 1); PG8_STAGE(PG8_SB(0, 0), b2, voffB);
            PG8_BAR; PG8_WAIT_L(0); PG8_MMA(0, 1, At, B1); PG8_BAR;
            PG8_LDA(At, 0, 1); PG8_STAGE(PG8_SA(0, 0), a2, voffA);
            PG8_BAR; PG8_WAIT_L(0); PG8_MMA(1, 0, At, B0); PG8_BAR; PG8_SCHED;
            PG8_STAGE(PG8_SB(0, 1), b2 + hstep, voffB);
            PG8_WAIT_V(6); PG8_BAR; PG8_MMA(1, 1, At, B1); PG8_BAR;
            PG8_LDB(B0, 1, 0); PG8_SCHED; PG8_LDA(At, 1, 0); PG8_STAGE(PG8_SA(0, 1), a2 + hstep, voffA);
            PG8_WAIT_L(8); PG8_BAR; PG8_WAIT_L(0); PG8_MMA(0, 0, At, B0); PG8_BAR; PG8_SCHED;
            PG8_LDB(B1, 1, 1); PG8_STAGE(PG8_SB(1, 0), b3, voffB);
            PG8_BAR; PG8_WAIT_L(0); PG8_MMA(0, 1, At, B1); PG8_BAR;
            PG8_LDA(At, 1, 1); PG8_STAGE(PG8_SA(1, 0), a3, voffA);
            PG8_BAR; PG8_WAIT_L(0); PG8_MMA(1, 0, At, B0); PG8_BAR; PG8_SCHED;
            PG8_STAGE(PG8_SB(1, 1), b3 + hstep, voffB);
            PG8_WAIT_V(6); PG8_BAR; PG8_MMA(1, 1, At, B1); PG8_BAR;
            }
        }
        if constexpr (ALIGN_EPI) { if (wr == 0) PG8_BAR; }
        if constexpr (!Epi::AFTER_DRAIN) { E(acc, cur, wr, wc, fr, fq); S.done(cur); }
        if (!has_next) break;
#pragma unroll
        for (int a = 0; a < 2; ++a)
#pragma unroll
            for (int b = 0; b < 2; ++b)
#pragma unroll
                for (int m = 0; m < 4; ++m)
#pragma unroll
                    for (int n = 0; n < 2; ++n) acc[a][b][m][n] = (f32x4){0.f, 0.f, 0.f, 0.f};
        cur = nxt; cA = nA; cB = nB; ++ui;
        if constexpr (ALIGN_EPI) { if (wr == 1) PG8_BAR; }
    }
    PG8_WAIT_V(0);
    if constexpr (!ALIGN_EPI) { if (wr == 0) PG8_BAR; }
    PG8_BAR;
    if constexpr (Epi::AFTER_DRAIN) { E.fused(acc, cur, wr, wc, fr, fq, lds, wid, lane); S.done(cur); }
#undef PG8_SA
#undef PG8_SB
#undef PG8_STAGE
#undef PG8_LDA
#undef PG8_LDB
#undef PG8_MMA
#undef PG8_WAIT_V
#undef PG8_WAIT_L
#undef PG8_BAR
#undef PG8_SCHED
}
}
#define LAS __attribute__((address_space(3)))
#define XB_TMO      128
#define XB_XCNT(j)  (256  + 64 * (j))
#define XB_XSUB(j)  (1280 + 64 * (j))
#define XB_XGEN(j)  (2304 + 64 * (j))
#define XB_TOP      3328
#define XB_TOPGEN   3392
#define XCD_BAR_WORDS 3456
#define XB_SPIN_CAP (1u << 18)

__device__ __forceinline__ unsigned xb_ld(unsigned* p)              { return __hip_atomic_load(p, __ATOMIC_RELAXED, __HIP_MEMORY_SCOPE_AGENT); }
__device__ __forceinline__ unsigned xb_add(unsigned* p, unsigned v) { return __hip_atomic_fetch_add(p, v, __ATOMIC_RELAXED, __HIP_MEMORY_SCOPE_AGENT); }
__device__ __forceinline__ unsigned xb_xcc_id() { return (unsigned)__builtin_amdgcn_s_getreg((3 << 11) | 20) & 0xFu; }
#define XB_SPIN(cond, bar) do { unsigned _sp = 0; while (cond) { __builtin_amdgcn_s_sleep(1); \
    if ((++_sp & 255u) == 0u) { if (xb_ld(&(bar)[XB_TMO])) break; if (_sp > XB_SPIN_CAP) { atomicAdd(&(bar)[XB_TMO], 1u); break; } } } } while (0)

struct XcdBarrier {
    unsigned* bar; unsigned x;
    volatile LAS unsigned* st;
};

__device__ __forceinline__ XcdBarrier xcd_barrier_post(unsigned* bar, volatile LAS unsigned* st) {
    XcdBarrier b; b.bar = bar; b.x = xb_xcc_id(); b.st = st;
    if (threadIdx.x == 0) (void)xb_add(&bar[XB_XCNT(b.x)], 1u);
    return b;
}
__device__ __forceinline__ void xcd_barrier_complete(unsigned* bar, unsigned x, unsigned& nloc, unsigned& nx) {
    const unsigned G = gridDim.x * gridDim.y * gridDim.z;
    unsigned sum, cnt, mine, sp = 0u;
    for (;;) {
        sum = 0u; cnt = 0u; mine = 0u;
#pragma unroll
        for (unsigned j = 0; j < 16; ++j) { const unsigned c = xb_ld(&bar[XB_XCNT(j)]); sum += c; cnt += (c > 0u) ? 1u : 0u; mine = (j == x) ? c : mine; }
        if (sum == G) break;
        __builtin_amdgcn_s_sleep(1);
        if ((++sp & 255u) == 0u) { if (xb_ld(&bar[XB_TMO])) break; if (sp > XB_SPIN_CAP) { atomicAdd(&bar[XB_TMO], 1u); break; } }
    }
    nloc = mine > 0u ? mine : 1u; nx = cnt > 0u ? cnt : 1u;
}

__device__ __forceinline__ void xcd_barrier(const XcdBarrier& b) {
    asm volatile("s_waitcnt vmcnt(0)" ::: "memory");
    __syncthreads();
    if (threadIdx.x == 0) {
        unsigned* bar = b.bar;
        __builtin_amdgcn_s_waitcnt(0);
        unsigned nloc = b.st[0], nx = b.st[1];
        if (nloc == 0u) { xcd_barrier_complete(bar, b.x, nloc, nx); b.st[0] = nloc; b.st[1] = nx; }
        const unsigned old = xb_add(&bar[XB_XSUB(b.x)], 1u);
        const unsigned gen = old / nloc;
        if (old + 1u == (gen + 1u) * nloc) {
            __builtin_amdgcn_fence(__ATOMIC_RELEASE, "agent");
            asm volatile("s_waitcnt vmcnt(0)" ::: "memory");
            const unsigned og = xb_add(&bar[XB_TOP], 1u);
            const unsigned tg = og / nx;
            if (og + 1u == (tg + 1u) * nx) xb_add(&bar[XB_TOPGEN], 1u);
            else XB_SPIN(xb_ld(&bar[XB_TOPGEN]) == tg, bar);
            __builtin_amdgcn_fence(__ATOMIC_ACQUIRE, "agent");
            xb_add(&bar[XB_XGEN(b.x)], 1u);
            asm volatile("s_waitcnt vmcnt(0)" ::: "memory");
        } else {
            XB_SPIN(xb_ld(&bar[XB_XGEN(b.x)]) == gen, bar);
            __builtin_amdgcn_fence(__ATOMIC_ACQUIRE, "agent");
            asm volatile("s_waitcnt vmcnt(0)" ::: "memory");
        }
    }
    __syncthreads();
}

#define GAS __attribute__((address_space(1)))
#define LAS __attribute__((address_space(3)))
typedef unsigned short bf16;
typedef float f32x4 __attribute__((ext_vector_type(4)));
typedef float f32x2 __attribute__((ext_vector_type(2)));
typedef float f32x16 __attribute__((ext_vector_type(16)));
typedef unsigned u32x4 __attribute__((ext_vector_type(4)));
typedef unsigned u32x2 __attribute__((ext_vector_type(2)));
typedef short bf16x8 __attribute__((ext_vector_type(8)));
typedef short s16x4 __attribute__((ext_vector_type(4)));
typedef __bf16 bf16x2_t __attribute__((ext_vector_type(2)));
typedef GAS unsigned gu32;

constexpr int NT = 512, NWAVES = 8;
constexpr int DM = 2048, MP = 8192, MS = 512, MT = MP + MS;
constexpr int NIN = 16400, N1 = 16384;
constexpr int CLP = 32, CLS = 4;
constexpr int NCH = 2048 / CLP;
constexpr float LN_EPS = 1e-5f, HN_EPS = 1e-6f;
constexpr float DN_ALPHA = 1.189207115002721f;
constexpr float RET_KS = 0.08838834764831845f;
constexpr size_t MiB = 1u << 20;
constexpr size_t WS_CTL = 0, CTL_ZERO_BYTES = 1 * MiB;
constexpr size_t WS_W1T = 2 * MiB;
constexpr size_t WS_W2T = 66 * MiB;
constexpr size_t WS_XB  = 74 * MiB;
constexpr size_t WS_BC  = 108 * MiB;
constexpr size_t WS_RT  = 142 * MiB;
constexpr size_t WS_QAT = 144 * MiB;
constexpr size_t WS_KAT = 161 * MiB, WS_KAH = 178 * MiB;
constexpr size_t WS_VA  = 195 * MiB;
constexpr size_t WS_QBT = 229 * MiB, WS_KBT = 246 * MiB, WS_KBH = 263 * MiB;
constexpr size_t WS_VB  = 280 * MiB;
constexpr size_t WS_PA  = 314 * MiB, WS_PB = 348 * MiB;
constexpr size_t WS_PG  = 382 * MiB;
constexpr size_t WS_PR  = 384 * MiB;
constexpr size_t WS_OA  = 388 * MiB, WS_OB = 422 * MiB, WS_MG = 456 * MiB;
constexpr size_t WS_END = 490 * MiB;
constexpr size_t OUT_Y = 0, OUT_SGP = 17825792, OUT_SRP = 19922944, OUT_SGS = 20971520, OUT_SRS = 88080384, OUT_TOTAL = 121634816;
constexpr int CW_QUEUE = 64;
constexpr int CW_BAR = 4096;
constexpr int LDS_BYTES = 160 * 1024;
constexpr int MISC_OFF = LDS_BYTES - 256;

#ifndef MK_N_LAUNCHES
#define MK_N_LAUNCHES 1
#endif
constexpr int N_PHASES = 7;

#define LDS_WAIT() asm volatile("s_waitcnt lgkmcnt(0)" ::: "memory")
#define VM_WAIT() asm volatile("s_waitcnt vmcnt(0)" ::: "memory")
__device__ __forceinline__ unsigned cvtpk(float lo, float hi) { f32x2 v = {lo, hi}; bf16x2_t b = __builtin_convertvector(v, bf16x2_t); return __builtin_bit_cast(unsigned, b); }
__device__ __forceinline__ float bf2f(unsigned short b) { return __builtin_bit_cast(float, (unsigned)b << 16); }
__device__ __forceinline__ float bflo(unsigned w) { return __builtin_bit_cast(float, w << 16); }
__device__ __forceinline__ float bfhi(unsigned w) { return __builtin_bit_cast(float, w & 0xffff0000u); }
__device__ __forceinline__ u32x4 pk8(f32x4 a, f32x4 b) { u32x4 w; w.x = cvtpk(a[0], a[1]); w.y = cvtpk(a[2], a[3]); w.z = cvtpk(b[0], b[1]); w.w = cvtpk(b[2], b[3]); return w; }
__device__ __forceinline__ float wave_sum(float v) {
#pragma unroll
    for (int o = 1; o < 64; o <<= 1) v += __shfl_xor(v, o);
    return v;
}
__device__ __forceinline__ s16x4 vtr(LAS unsigned char* p) { typedef short v4i16_t __attribute__((ext_vector_type(4))); return __builtin_bit_cast(s16x4, __builtin_amdgcn_ds_read_tr16_b64_v4i16((LAS v4i16_t*)p)); }
#define MFMA32(a, b, c) __builtin_amdgcn_mfma_f32_32x32x16_bf16((a), (b), (c), 0, 0, 0)
__device__ __forceinline__ int crow(int reg, int h) { return (reg & 3) + 8 * (reg >> 2) + 4 * h; }
__device__ __forceinline__ float lg2gamma(int h) {
    const float t[8] = {-0.045803689613124789f, -0.022720076500083529f, -0.011315313227834146f, -0.0056465631411420627f, -0.0028205190623786626f, -0.0014095702546713536f, -0.00070461297658937271f, -0.00035226347162902138f};
    float r = t[0];
#pragma unroll
    for (int i = 1; i < 8; ++i) r = (h == i) ? t[i] : r;
    return r;
}

struct EpiG1 {
    static constexpr bool PERM = true, AFTER_DRAIN = false;
    bf16 *QAT, *KAT, *KAH, *VA, *QBT, *KBT, *KBH, *VB, *PA, *PB; const float* BC; const float* RT;
    __device__ __forceinline__ void operator()(const f32x4 (&acc)[2][2][4][2], const pg8::Unit& u, int wr, int wc, int fr, int fq) const {
        const int pn = u.pn, rbase = u.pm * 256 + wr * 64 + fr, cq = wc * 32 + 8 * fq;
        if (pn < 4) {
#pragma unroll
            for (int ai = 0; ai < 2; ++ai)
#pragma unroll
                for (int m = 0; m < 4; ++m) { const int r = rbase + ai * 128 + m * 16;
#pragma unroll
                    for (int bj = 0; bj < 2; ++bj) { const size_t o = (size_t)r * 1024 + pn * 256 + bj * 128 + cq;
                        const f32x4 b0 = *(const f32x4*)(BC + o), b1 = *(const f32x4*)(BC + o + 4); f32x4 v0 = acc[ai][bj][m][0], v1 = acc[ai][bj][m][1];
#pragma unroll
                        for (int j = 0; j < 4; ++j) { v0[j] *= 0.0625f * __expf(b0[j]); v1[j] *= 0.0625f * __expf(b1[j]); }
                        *(u32x4*)(QAT + o) = pk8(v0, v1); } }
        } else if (pn < 8) {
#pragma unroll
            for (int ai = 0; ai < 2; ++ai)
#pragma unroll
                for (int m = 0; m < 4; ++m) { const int r = rbase + ai * 128 + m * 16; const int rl = r < MP ? (r | (CLP - 1)) : (r | (CLS - 1));
#pragma unroll
                    for (int bj = 0; bj < 2; ++bj) { const int col = (pn - 4) * 256 + bj * 128 + cq; const size_t o = (size_t)r * 1024 + col, ol = (size_t)rl * 1024 + col;
                        const f32x4 b0 = *(const f32x4*)(BC + o), b1 = *(const f32x4*)(BC + o + 4), l0 = *(const f32x4*)(BC + ol), l1 = *(const f32x4*)(BC + ol + 4);
                        const f32x4 a0 = acc[ai][bj][m][0], a1 = acc[ai][bj][m][1]; f32x4 t0, t1, h0, h1;
#pragma unroll
                        for (int j = 0; j < 4; ++j) { t0[j] = a0[j] * __expf(-b0[j]); t1[j] = a1[j] * __expf(-b1[j]); h0[j] = a0[j] * __expf(l0[j] - b0[j]); h1[j] = a1[j] * __expf(l1[j] - b1[j]); }
                        *(u32x4*)(KAT + o) = pk8(t0, t1); *(u32x4*)(KAH + o) = pk8(h0, h1); } }
        } else if (pn < 16 || (pn >= 24 && pn < 32)) {
            bf16* V = pn < 16 ? VA : VB; const int ct = (pn < 16 ? pn - 8 : pn - 24) * 256;
#pragma unroll
            for (int ai = 0; ai < 2; ++ai)
#pragma unroll
                for (int m = 0; m < 4; ++m) { const int r = rbase + ai * 128 + m * 16;
#pragma unroll
                    for (int bj = 0; bj < 2; ++bj) *(u32x4*)(V + (size_t)r * 2048 + ct + bj * 128 + cq) = pk8(acc[ai][bj][m][0], acc[ai][bj][m][1]); }
        } else if (pn < 24) {
            const bool isq = pn < 20; const int hp = (pn & 3) * 2;
#pragma unroll
            for (int ai = 0; ai < 2; ++ai)
#pragma unroll
                for (int m = 0; m < 4; ++m) { const int r = rbase + ai * 128 + m * 16; const bool pr = r < MP;
                    const int ridx = pr ? (r & 2047) : 2048 + (r & 3), ic = pr ? (r & (CLP - 1)) : (r & (CLS - 1)), cl = pr ? CLP : CLS;
                    const float* rt = RT + ((size_t)ridx * 64 + 16 * wc + 4 * fq) * 2;
                    const f32x4 ta = *(const f32x4*)rt, tb = *(const f32x4*)(rt + 4);
#pragma unroll
                    for (int bj = 0; bj < 2; ++bj) { const int head = hp + bj; const float lg = lg2gamma(head);
                        const f32x4 a0 = acc[ai][bj][m][0], a1 = acc[ai][bj][m][1]; f32x4 y0, y1;
                        y0[0] = a0[0] * ta[0] - a0[1] * ta[1]; y0[1] = a0[1] * ta[0] + a0[0] * ta[1]; y0[2] = a0[2] * ta[2] - a0[3] * ta[3]; y0[3] = a0[3] * ta[2] + a0[2] * ta[3];
                        y1[0] = a1[0] * tb[0] - a1[1] * tb[1]; y1[1] = a1[1] * tb[0] + a1[0] * tb[1]; y1[2] = a1[2] * tb[2] - a1[3] * tb[3]; y1[3] = a1[3] * tb[2] + a1[2] * tb[3];
                        const size_t o = (size_t)r * 1024 + head * 128 + cq;
                        if (isq) { const float sc = __builtin_amdgcn_exp2f((float)(ic + 1) * lg); *(u32x4*)(QBT + o) = pk8(y0 * sc, y1 * sc); }
                        else { const float st = RET_KS * __builtin_amdgcn_exp2f(-(float)(ic + 1) * lg), sh = RET_KS * __builtin_amdgcn_exp2f((float)(cl - 1 - ic) * lg);
                            *(u32x4*)(KBT + o) = pk8(y0 * st, y1 * st); *(u32x4*)(KBH + o) = pk8(y0 * sh, y1 * sh); } } }
        } else {
            bf16* P = pn < 48 ? PA : PB; const int ct = (pn < 48 ? pn - 32 : pn - 48) * 128;
#pragma unroll
            for (int ai = 0; ai < 2; ++ai)
#pragma unroll
                for (int m = 0; m < 4; ++m) { const int r = rbase + ai * 128 + m * 16; f32x4 p0, p1;
#pragma unroll
                    for (int j = 0; j < 4; ++j) { const float z0 = acc[ai][0][m][0][j], g0 = acc[ai][1][m][0][j], z1 = acc[ai][0][m][1][j], g1 = acc[ai][1][m][1][j];
                        p0[j] = z0 * __builtin_amdgcn_rcpf((1.f + __expf(-z0)) * (1.f + __expf(-g0))); p1[j] = z1 * __builtin_amdgcn_rcpf((1.f + __expf(-z1)) * (1.f + __expf(-g1))); }
                    *(u32x4*)(P + (size_t)r * 2048 + ct + cq) = pk8(p0, p1); }
        }
    }
};
struct EpiG2 {
    static constexpr bool PERM = false, AFTER_DRAIN = false;
    const float* xp; const float* xs; float* out;
    __device__ __forceinline__ void operator()(const f32x4 (&acc)[2][2][4][2], const pg8::Unit& u, int wr, int wc, int fr, int fq) const {
        const int row0 = u.pm * 256 + wr * 64 + fr, col0 = u.pn * 256 + wc * 32 + 4 * fq;
#pragma unroll
        for (int ai = 0; ai < 2; ++ai)
#pragma unroll
            for (int m = 0; m < 4; ++m) { const int r = row0 + ai * 128 + m * 16; const float* xr = (r < MP ? xp + (size_t)r * DM : xs + (size_t)(r - MP) * DM) + col0; float* orow = out + (size_t)r * DM + col0;
#pragma unroll
                for (int bj = 0; bj < 2; ++bj)
#pragma unroll
                    for (int n = 0; n < 2; ++n) { const f32x4 xv = *(const f32x4*)(xr + bj * 128 + n * 16); *(f32x4*)(orow + bj * 128 + n * 16) = xv * DN_ALPHA + acc[ai][bj][m][n]; } }
    }
};

struct Args { const float* in[13]; float* out; unsigned char* ws; int ph_lo, ph_hi; };

__device__ __forceinline__ int w1_src_col(int r) {
    if (r < 4096) return r;
    if (r < 5120) return 6160 + (r - 4096);
    if (r < 6144) return 7184 + (r - 5120);
    if (r < 8192) return 8208 + (r - 6144);
    if (r < 12288) { const int t = (r - 8192) >> 8, j = (r - 8192) & 255; return j < 128 ? 4096 + 128 * t + j : 12304 + 128 * t + (j - 128); }
    { const int t = (r - 12288) >> 8, j = (r - 12288) & 255; return j < 128 ? 10256 + 128 * t + j : 14352 + 128 * t + (j - 128); }
}
__device__ __forceinline__ void p0_transpose_item(const float* W, int ldw, int srcn, int k0, bf16* WT, int K, int dstn, LAS float* scr, int lane) {
#pragma unroll 8
    for (int i = 0; i < 32; ++i) { const int kk = 2 * i + (lane >> 5); scr[kk * 33 + (lane & 31)] = W[(size_t)(k0 + kk) * ldw + srcn + (lane & 31)]; }
    LDS_WAIT(); asm volatile("" ::: "memory");
    const int c = lane & 7;
#pragma unroll
    for (int j = 0; j < 4; ++j) { const int n = (lane >> 3) + 8 * j; const LAS float* s = scr + (8 * c) * 33 + n;
        u32x4 o; o.x = cvtpk(s[0 * 33], s[1 * 33]); o.y = cvtpk(s[2 * 33], s[3 * 33]); o.z = cvtpk(s[4 * 33], s[5 * 33]); o.w = cvtpk(s[6 * 33], s[7 * 33]);
        *(u32x4*)(WT + (size_t)(dstn + n) * K + k0 + 8 * c) = o; }
    LDS_WAIT(); asm volatile("" ::: "memory");
}
template <int N> __device__ __forceinline__ void rs_step(float (&v)[64], int lane) {
    const bool up = (lane & (N / 2)) != 0;
#pragma unroll
    for (int i = 0; i < N / 2; ++i) { const float a0 = v[i], b0 = v[i + N / 2]; const float send = up ? a0 : b0, keep = up ? b0 : a0; v[i] = keep + __shfl_xor(send, N / 2); }
}
__device__ __forceinline__ void sincos_f64(double a, float& c, float& s) {
    const double n = __builtin_rint(a * 0.63661977236758134308);
    double r = __builtin_fma(-n, 1.57079632673412561417e+00, a); r = __builtin_fma(-n, 6.07710050650619224932e-11, r);
    const double r2 = r * r;
    double sp = -1.0 / 1307674368000.0; sp = sp * r2 + 1.0 / 6227020800.0; sp = sp * r2 - 1.0 / 39916800.0; sp = sp * r2 + 1.0 / 362880.0; sp = sp * r2 - 1.0 / 5040.0; sp = sp * r2 + 1.0 / 120.0; sp = sp * r2 - 1.0 / 6.0; sp = sp * r2 + 1.0;
    const double sr = sp * r;
    double cp = 1.0 / 20922789888000.0; cp = cp * r2 - 1.0 / 87178291200.0; cp = cp * r2 + 1.0 / 479001600.0; cp = cp * r2 - 1.0 / 3628800.0; cp = cp * r2 + 1.0 / 40320.0; cp = cp * r2 - 1.0 / 720.0; cp = cp * r2 + 1.0 / 24.0; cp = cp * r2 - 0.5; cp = cp * r2 + 1.0;
    const int q = ((int)n) & 3;
    const double cc = (q == 0) ? cp : (q == 1) ? -sr : (q == 2) ? -cp : sr;
    const double ss = (q == 0) ? sr : (q == 1) ? cp : (q == 2) ? -sr : -cp;
    c = (float)cc; s = (float)ss;
}
__device__ __forceinline__ float inv_freq(int i) {
    const float t[64] = {1.000000000e+00f, 8.639885187e-01f, 7.464760542e-01f, 6.449466944e-01f, 5.572264791e-01f, 4.814372659e-01f, 4.159561992e-01f, 3.593813777e-01f, 3.105013072e-01f, 2.682695687e-01f, 2.317818254e-01f, 2.002568096e-01f, 1.730195731e-01f, 1.494869143e-01f, 1.291549653e-01f, 1.115884036e-01f, 9.641107917e-02f, 8.329805732e-02f, 7.196855545e-02f, 6.218000501e-02f, 5.372281000e-02f, 4.641588405e-02f, 4.010278732e-02f, 3.464834765e-02f, 2.993576974e-02f, 2.586415969e-02f, 2.234633639e-02f, 1.930697635e-02f, 1.668100618e-02f, 1.441219542e-02f, 1.245197095e-02f, 1.075835899e-02f, 9.295095690e-03f, 8.030855097e-03f, 6.938566454e-03f, 5.994840525e-03f, 5.179473199e-03f, 4.475005437e-03f, 3.866353072e-03f, 3.340484342e-03f, 2.886139555e-03f, 2.493591513e-03f, 2.154434333e-03f, 1.861406374e-03f, 1.608233666e-03f, 1.389495214e-03f, 1.200507861e-03f, 1.037224894e-03f, 8.961504791e-04f, 7.742635789e-04f, 6.689548027e-04f, 5.779692437e-04f, 4.993587499e-04f, 4.314401885e-04f, 3.727593285e-04f, 3.220597573e-04f, 2.782559313e-04f, 2.404098923e-04f, 2.077113895e-04f, 1.794602285e-04f, 1.550515735e-04f, 1.339627634e-04f, 1.157422957e-04f, 9.999999747e-05f};
    return t[i];
}
__device__ __forceinline__ float logsigmoid(float g) { return fminf(g, 0.f) - log1pf(__expf(-fabsf(g))); }

__device__ __forceinline__ void phase0(const Args& a, LAS unsigned char* lds, int vcu, int G, int tid) {
    const int lane = tid & 63, wave = __builtin_amdgcn_readfirstlane(tid >> 6);
    unsigned char* ws = a.ws;
    { float* RT = (float*)(ws + WS_RT);
      for (int e = vcu * NT + tid; e < 2052 * 64; e += G * NT) { const int ridx = e >> 6, i = e & 63; const int pos = ridx < 2048 ? ridx : 16384 + (ridx - 2048);
          const float ang = __fmul_rn((float)pos, inv_freq(i)); float c, s; sincos_f64((double)ang, c, s); *(f32x2*)(RT + (size_t)e * 2) = (f32x2){c, s}; } }
    { const float* w_in = a.in[4]; const float* w_lr = a.in[5]; const float* b_lr = a.in[6];
      bf16* XB = (bf16*)(ws + WS_XB); float* BC = (float*)(ws + WS_BC);
      LAS float* T = (LAS float*)lds;
      LAS float* lrs = (LAS float*)(lds + 131072);
      bool staged = false;
      for (int it = vcu; it < MT / 32; it += G) {
          if (!staged) {
              for (int idx = tid; idx < 8192; idx += NT) { const int k = idx >> 2, c = idx & 3; const f32x4 v = *(const f32x4*)(w_in + (size_t)k * NIN + 6144 + 4 * c);
                  const int pos = ((k & 255) >> 2) + 64 * (k & 3) + (k & ~255); *(LAS f32x4*)(T + (size_t)(c * 2048 + pos) * 4) = v; }
              staged = true; __syncthreads(); }
          const int row0 = it * 32, clen = row0 < MP ? CLP : CLS;
          {
            const float* xr[4];
#pragma unroll
            for (int rr = 0; rr < 4; ++rr) { const int r = row0 + 4 * wave + rr; xr[rr] = r < MP ? a.in[0] + (size_t)r * DM : a.in[1] + (size_t)(r - MP) * DM; }
            float acc[64];
#pragma unroll
            for (int i = 0; i < 64; ++i) acc[i] = 0.f;
#pragma unroll 1
            for (int j = 0; j < 8; ++j) {
                f32x4 xv[4];
#pragma unroll
                for (int rr = 0; rr < 4; ++rr) { xv[rr] = *(const f32x4*)(xr[rr] + 4 * lane + 256 * j);
                    u32x2 w; w.x = cvtpk(xv[rr][0], xv[rr][1]); w.y = cvtpk(xv[rr][2], xv[rr][3]); *(u32x2*)(XB + (size_t)(row0 + 4 * wave + rr) * DM + 4 * lane + 256 * j) = w; }
#pragma unroll
                for (int i = 0; i < 4; ++i)
#pragma unroll
                    for (int c = 0; c < 4; ++c) { const f32x4 w = *(const LAS f32x4*)(T + (size_t)(c * 2048 + lane + 64 * i + 256 * j) * 4);
#pragma unroll
                        for (int rr = 0; rr < 4; ++rr)
#pragma unroll
                            for (int e = 0; e < 4; ++e) acc[rr * 16 + 4 * c + e] += xv[rr][i] * w[e]; }
            }
            rs_step<64>(acc, lane); rs_step<32>(acc, lane); rs_step<16>(acc, lane); rs_step<8>(acc, lane); rs_step<4>(acc, lane); rs_step<2>(acc, lane);
            lrs[64 * wave + lane] = acc[0];
          }
          __syncthreads();
#pragma unroll 1
          for (int cc = 0; cc < 2; ++cc) { const int c = tid + 512 * cc; float w[16];
#pragma unroll
              for (int j = 0; j < 16; ++j) w[j] = w_lr[j * 1024 + c];
              const float b = b_lr[c]; float run = 0.f;
#pragma unroll 4
              for (int t = 0; t < 32; ++t) { if ((t & (clen - 1)) == 0) run = 0.f; float g = b;
#pragma unroll
                  for (int q = 0; q < 4; ++q) { const f32x4 l = *(const LAS f32x4*)(lrs + t * 16 + 4 * q); g += l[0] * w[4 * q] + l[1] * w[4 * q + 1] + l[2] * w[4 * q + 2] + l[3] * w[4 * q + 3]; }
                  run += logsigmoid(g) * 0.0625f; BC[(size_t)(row0 + t) * 1024 + c] = run; } }
          __syncthreads();
      } }
    __syncthreads();
    { LAS float* scr = (LAS float*)(lds + wave * 16384);
      const int gw = vcu * NWAVES + wave, NGW = G * NWAVES;
      constexpr int I1 = (DM / 64) * (N1 / 32), I2 = (DM / 64) * (DM / 32);
      bf16* W1T = (bf16*)(ws + WS_W1T); bf16* W2T = (bf16*)(ws + WS_W2T);
      for (int it = gw; it < I1 + I2; it += NGW) {
          if (it < I1) { const int kb = it / (N1 / 32), nb = it % (N1 / 32); p0_transpose_item(a.in[4], NIN, w1_src_col(32 * nb), 64 * kb, W1T, DM, 32 * nb, scr, lane); }
          else { const int r = it - I1, kb = r / (DM / 32), nb = r % (DM / 32); p0_transpose_item(a.in[10], DM, 32 * nb, 64 * kb, W2T, DM, 32 * nb, scr, lane); }
      } }
}

__device__ __forceinline__ void phase2(const Args& a, int vcu, int G, int tid) {
    const int lane = tid & 63, wave = __builtin_amdgcn_readfirstlane(tid >> 6), r = lane & 31, hh = lane >> 5;
    unsigned char* ws = a.ws; const int gw = vcu * NWAVES + wave, NGW = G * NWAVES;
    for (int it = gw; it < 1024 + 2048; it += NGW) {
        const bf16 *Qp, *Kp; bf16* Pp; int nst;
        if (it < 1024) { const int b = it >> 8, h = (it >> 6) & 3, ch = it & 63; const size_t off = (size_t)(b * 2048 + ch * 32) * 1024 + h * 256;
            Qp = (const bf16*)(ws + WS_QAT) + off; Kp = (const bf16*)(ws + WS_KAT) + off; Pp = (bf16*)(ws + WS_PG) + (size_t)it * 1024; nst = 16; }
        else { const int i2 = it - 1024, b = i2 >> 9, h = (i2 >> 6) & 7, ch = i2 & 63; const size_t off = (size_t)(b * 2048 + ch * 32) * 1024 + h * 128;
            Qp = (const bf16*)(ws + WS_QBT) + off; Kp = (const bf16*)(ws + WS_KBT) + off; Pp = (bf16*)(ws + WS_PR) + (size_t)i2 * 1024; nst = 8; }
        f32x16 d;
#pragma unroll
        for (int i = 0; i < 16; ++i) d[i] = 0.f;
        const bf16* qa = Qp + (size_t)r * 1024 + 8 * hh; const bf16* ka = Kp + (size_t)r * 1024 + 8 * hh;
        for (int s = 0; s < nst; ++s) { const bf16x8 af = *(const bf16x8*)(ka + 16 * s), bq = *(const bf16x8*)(qa + 16 * s); d = MFMA32(af, bq, d); }
#pragma unroll
        for (int g = 0; g < 4; ++g) { const int s0 = 8 * g + 4 * hh; float v[4];
#pragma unroll
            for (int j = 0; j < 4; ++j) v[j] = (s0 + j <= r) ? d[4 * g + j] : 0.f;
            u32x2 w; w.x = cvtpk(v[0], v[1]); w.y = cvtpk(v[2], v[3]); *(u32x2*)(Pp + r * 32 + s0) = w; }
    }
}

template <int KD, int VD>
__device__ __forceinline__ void scan_item(LAS unsigned char* lds, const bf16* Qg, const bf16* Kg, const bf16* Vg, const bf16* Pg, const float* BCg, float dscal, bf16* Og, float* Sg, int s_stride, int tid) {
    constexpr int QS = KD * 2 + 8, KS = KD * 2 + 64, VS = VD * 2 + 64, PS = 80;
    constexpr int OFF_Q = 0, OFF_K = OFF_Q + 32 * QS, OFF_V = OFF_K + 32 * KS, OFF_P = OFF_V + 32 * VS, OFF_D = OFF_P + 32 * PS, OFF_X = OFF_D + KD * 4;
    constexpr int QPT = (32 * KD / 8) / NT, VPT = (32 * VD / 8) / NT, QPR = KD / 8, VPR = VD / 8;
    constexpr int NVQ = VD / 32, NKH = 8 / NVQ;
    static_assert(QPT >= 1 && VPT >= 1 && OFF_X + 16384 <= 131072, "scan LDS map");
    const int lane = tid & 63, wave = __builtin_amdgcn_readfirstlane(tid >> 6), r = lane & 31, hh = lane >> 5;
    const int vq = wave % NVQ, kh = wave / NVQ;
        const int q4 = (lane & 15) >> 2, p4 = lane & 3, blk = (lane >> 4) & 1;
    const int vaddr = OFF_V + (8 * hh + q4) * VS + (32 * vq + 16 * blk + 4 * p4) * 2;
    const int kaddr = OFF_K + (8 * hh + q4) * KS + (128 * kh + 16 * blk + 4 * p4) * 2;
    const int qaddr = OFF_Q + r * QS + (128 * kh + 4 * hh) * 2;
    const int paddr = OFF_P + r * PS + 16 * hh;
    const int daddr = OFF_D + (128 * kh + 4 * hh) * 4;
    LAS float* xb = (LAS float*)(lds + OFF_X);
    f32x16 S[4];
#pragma unroll
    for (int kt = 0; kt < 4; ++kt)
#pragma unroll
        for (int i = 0; i < 16; ++i) S[kt][i] = 0.f;
    u32x4 rq[QPT], rk[QPT], rv[VPT], rm;
#define SCAN_LOAD(c) do { const int r0_ = (c) * 32; \
        _Pragma("unroll") for (int i_ = 0; i_ < QPT; ++i_) { const int p_ = tid + NT * i_, row_ = p_ / QPR, pc_ = p_ % QPR; \
            rq[i_] = *(const u32x4*)(Qg + (size_t)(r0_ + row_) * 1024 + pc_ * 8); rk[i_] = *(const u32x4*)(Kg + (size_t)(r0_ + row_) * 1024 + pc_ * 8); } \
        _Pragma("unroll") for (int i_ = 0; i_ < VPT; ++i_) { const int p_ = tid + NT * i_, row_ = p_ / VPR, pc_ = p_ % VPR; rv[i_] = *(const u32x4*)(Vg + (size_t)(r0_ + row_) * 2048 + pc_ * 8); } \
        if (tid < 128) rm = *(const u32x4*)(Pg + (size_t)(c) * 1024 + tid * 8); \
        else if (BCg != nullptr && tid < 128 + KD / 4) rm = *(const u32x4*)(BCg + (size_t)(r0_ + 31) * 1024 + (tid - 128) * 4); } while (0)
    SCAN_LOAD(0);
#pragma unroll 1
    for (int c = 0; c < NCH; ++c) {
#pragma unroll
        for (int i = 0; i < QPT; ++i) { const int p = tid + NT * i, row = p / QPR, pc = p % QPR;
            *(LAS u32x2*)(lds + OFF_Q + row * QS + pc * 16) = (u32x2){rq[i].x, rq[i].y}; *(LAS u32x2*)(lds + OFF_Q + row * QS + pc * 16 + 8) = (u32x2){rq[i].z, rq[i].w};
            *(LAS u32x4*)(lds + OFF_K + row * KS + pc * 16) = rk[i]; }
#pragma unroll
        for (int i = 0; i < VPT; ++i) { const int p = tid + NT * i, row = p / VPR, pc = p % VPR; *(LAS u32x4*)(lds + OFF_V + row * VS + pc * 16) = rv[i]; }
        if (tid < 128) *(LAS u32x4*)(lds + OFF_P + (tid >> 2) * PS + (tid & 3) * 16) = rm;
        else if (BCg != nullptr && tid < 128 + KD / 4) { f32x4 e;
#pragma unroll
            for (int j = 0; j < 4; ++j) e[j] = __expf(__builtin_bit_cast(float, rm[j]));
            *(LAS f32x4*)(lds + OFF_D + (tid - 128) * 16) = e; }
        __syncthreads();
        if (c + 1 < NCH) SCAN_LOAD(c + 1);
        bf16x8 vf[2];
#pragma unroll
        for (int s = 0; s < 2; ++s) { const s16x4 lo = vtr(lds + vaddr + (16 * s) * VS), hi = vtr(lds + vaddr + (16 * s + 4) * VS); vf[s] = __builtin_shufflevector(lo, hi, 0, 1, 2, 3, 4, 5, 6, 7); }
        f32x16 O;
#pragma unroll
        for (int i = 0; i < 16; ++i) O[i] = 0.f;
#pragma unroll
        for (int kt = 0; kt < 4; ++kt)
#pragma unroll
            for (int s = 0; s < 2; ++s) {
                const s16x4 alo = *(const LAS s16x4*)(lds + qaddr + (32 * kt + 16 * s) * 2), ahi = *(const LAS s16x4*)(lds + qaddr + (32 * kt + 16 * s + 8) * 2);
                const bf16x8 A = __builtin_shufflevector(alo, ahi, 0, 1, 2, 3, 4, 5, 6, 7);
                u32x4 pb; pb.x = cvtpk(S[kt][8 * s + 0], S[kt][8 * s + 1]); pb.y = cvtpk(S[kt][8 * s + 2], S[kt][8 * s + 3]); pb.z = cvtpk(S[kt][8 * s + 4], S[kt][8 * s + 5]); pb.w = cvtpk(S[kt][8 * s + 6], S[kt][8 * s + 7]);
                O = MFMA32(A, __builtin_bit_cast(bf16x8, pb), O); }
        if (kh == 0) {
#pragma unroll
            for (int s = 0; s < 2; ++s) { const bf16x8 A = *(const LAS bf16x8*)(lds + paddr + 32 * s); O = MFMA32(A, vf[s], O); } }
        if (NKH == 2 && kh == 1) {
#pragma unroll
            for (int i = 0; i < 16; ++i) xb[(vq * 16 + i) * 64 + lane] = O[i]; }
#pragma unroll
        for (int kt = 0; kt < 4; ++kt)
#pragma unroll
            for (int g = 0; g < 4; ++g) { f32x4 dv;
                if (BCg != nullptr) { const f32x4 bl = *(const f32x4*)(BCg + (size_t)(c * 32 + 31) * 1024 + 128 * kh + 4 * hh + 32 * kt + 8 * g); dv = (f32x4){__expf(bl[0]), __expf(bl[1]), __expf(bl[2]), __expf(bl[3])}; } else dv = (f32x4){dscal, dscal, dscal, dscal};
#pragma unroll
                for (int j = 0; j < 4; ++j) S[kt][4 * g + j] *= dv[j]; }
#pragma unroll
        for (int kt = 0; kt < 4; ++kt)
#pragma unroll
            for (int s = 0; s < 2; ++s) { const s16x4 lo = vtr(lds + kaddr + kt * 64 + (16 * s) * KS), hi = vtr(lds + kaddr + kt * 64 + (16 * s + 4) * KS);
                S[kt] = MFMA32(__builtin_shufflevector(lo, hi, 0, 1, 2, 3, 4, 5, 6, 7), vf[s], S[kt]); }
        __syncthreads();
        if (kh == 0) {
            if (NKH == 2) {
#pragma unroll
                for (int i = 0; i < 16; ++i) O[i] += xb[(vq * 16 + i) * 64 + lane]; }
            bf16* op = Og + (size_t)(c * 32) * 2048 + 32 * vq + r;
#pragma unroll
            for (int i = 0; i < 16; ++i) op[(size_t)crow(i, hh) * 2048] = (bf16)(cvtpk(O[i], 0.f) & 0xffffu);
        }
    }
#undef SCAN_LOAD
#pragma unroll
    for (int kt = 0; kt < 4; ++kt)
#pragma unroll
        for (int i = 0; i < 16; ++i) Sg[(size_t)(128 * kh + 32 * kt + crow(i, hh)) * s_stride + 32 * vq + r] = S[kt][i];
    __syncthreads();
}

template <int KD, int VW, int VDF>
__device__ __forceinline__ void stream_item(LAS unsigned char* lds, const float* S0, float* S1, const bf16* Qp, const bf16* Ktp, const bf16* Khp, const float* BCl, float dscal,
                                            const bf16* Vp, bf16* Op, int tid) {
    constexpr int CG = VW / 4, RG = NT / CG, RPT = KD / RG;
    static_assert(RPT == 16, "stream item geometry");
    LAS float* sc = (LAS float*)lds;
    LAS float* wred = (LAS float*)(lds + 12288);
    LAS float* pp = (LAS float*)(lds + 12288 + 512);
    LAS float* red = (LAS float*)(lds + 16384);
    const int lane = tid & 63, wave = __builtin_amdgcn_readfirstlane(tid >> 6);
    if (tid < KD) { const int k = tid; float q[4], kt[4], kh[4];
#pragma unroll
        for (int t = 0; t < 4; ++t) { q[t] = bf2f(Qp[(size_t)t * 1024 + k]); kt[t] = bf2f(Ktp[(size_t)t * 1024 + k]); kh[t] = bf2f(Khp[(size_t)t * 1024 + k]); }
        const float d = BCl != nullptr ? __expf(BCl[k]) : dscal;
        *(LAS f32x4*)(sc + k * 12) = (f32x4){q[0], q[1], q[2], q[3]}; *(LAS f32x4*)(sc + k * 12 + 4) = (f32x4){kh[0], kh[1], kh[2], kh[3]}; sc[k * 12 + 8] = d;
#pragma unroll
        for (int t = 0; t < 4; ++t)
#pragma unroll
            for (int s = 0; s < 4; ++s) { const float v = wave_sum(q[t] * kt[s]); if (lane == 0) wred[wave * 16 + t * 4 + s] = v; }
    }
    __syncthreads();
    if (tid < 16) { float v = 0.f;
#pragma unroll
        for (int w = 0; w < KD / 64; ++w) v += wred[w * 16 + tid];
        pp[tid] = ((tid & 3) <= (tid >> 2)) ? v : 0.f; }
    const int rg = tid / CG, cg = tid % CG;
    f32x4 vv[4];
#pragma unroll
    for (int s = 0; s < 4; ++s) { const u32x2 w = *(const u32x2*)(Vp + (size_t)s * 2048 + 4 * cg); vv[s] = (f32x4){bflo(w.x), bfhi(w.x), bflo(w.y), bfhi(w.y)}; }
    f32x4 O[4];
#pragma unroll
    for (int t = 0; t < 4; ++t) O[t] = (f32x4){0.f, 0.f, 0.f, 0.f};
#pragma unroll
    for (int half = 0; half < 2; ++half) {
        f32x4 sv[8];
#pragma unroll
        for (int i = 0; i < 8; ++i) { const int k = rg + RG * (8 * half + i); sv[i] = __builtin_nontemporal_load((const f32x4*)(S0 + (size_t)k * VDF + 4 * cg)); }
#pragma unroll
        for (int i = 0; i < 8; ++i) { const int k = rg + RG * (8 * half + i);
            const f32x4 q = *(const LAS f32x4*)(sc + k * 12), kh = *(const LAS f32x4*)(sc + k * 12 + 4); const float d = sc[k * 12 + 8];
            f32x4 sn = sv[i] * d;
#pragma unroll
            for (int s = 0; s < 4; ++s) sn += vv[s] * kh[s];
            __builtin_nontemporal_store(sn, (f32x4*)(S1 + (size_t)k * VDF + 4 * cg));
#pragma unroll
            for (int t = 0; t < 4; ++t) O[t] += sv[i] * q[t]; }
    }
#pragma unroll
    for (int t = 0; t < 4; ++t) *(LAS f32x4*)(red + (size_t)(rg * 4 + t) * VW + 4 * cg) = O[t];
    __syncthreads();
    for (int idx = tid; idx < 4 * VW; idx += NT) { const int t = idx / VW, v = idx % VW; float o = 0.f;
#pragma unroll
        for (int g = 0; g < RG; ++g) o += red[(size_t)(g * 4 + t) * VW + v];
#pragma unroll
        for (int s = 0; s < 4; ++s) o += pp[t * 4 + s] * bf2f(Vp[(size_t)s * 2048 + v]);
        Op[(size_t)t * 2048 + v] = (bf16)(cvtpk(o, 0.f) & 0xffffu); }
    __syncthreads();
}

__device__ __forceinline__ void phase3(const Args& a, LAS unsigned char* lds, gu32* ctl, int tid) {
    unsigned char* ws = a.ws; const int bx = blockIdx.x;
    const bf16* QAT = (const bf16*)(ws + WS_QAT); const bf16* KAT = (const bf16*)(ws + WS_KAT); const bf16* KAH = (const bf16*)(ws + WS_KAH); const bf16* VA = (const bf16*)(ws + WS_VA);
    const bf16* QBT = (const bf16*)(ws + WS_QBT); const bf16* KBT = (const bf16*)(ws + WS_KBT); const bf16* KBH = (const bf16*)(ws + WS_KBH); const bf16* VB = (const bf16*)(ws + WS_VB);
    const float* BC = (const float*)(ws + WS_BC); bf16* OA = (bf16*)(ws + WS_OA); bf16* OB = (bf16*)(ws + WS_OB);
    if (bx < 64) { const int b = bx >> 4, h = (bx >> 2) & 3, vs = bx & 3; const size_t ro = (size_t)b * 2048;
        scan_item<256, 128>(lds, QAT + ro * 1024 + h * 256, KAH + ro * 1024 + h * 256, VA + ro * 2048 + h * 512 + vs * 128, (const bf16*)(ws + WS_PG) + (size_t)((b * 4 + h) * NCH) * 1024,
                            BC + ro * 1024 + h * 256, 0.f, OA + ro * 2048 + h * 512 + vs * 128, a.out + OUT_SGP + (size_t)((b * 4 + h) * 256) * 512 + vs * 128, 512, tid);
    } else if (bx < 96) { const int i = bx - 64, b = i >> 3, h = i & 7; const size_t ro = (size_t)b * 2048;
        scan_item<128, 256>(lds, QBT + ro * 1024 + h * 128, KBH + ro * 1024 + h * 128, VB + ro * 2048 + h * 256, (const bf16*)(ws + WS_PR) + (size_t)((b * 8 + h) * NCH) * 1024,
                            nullptr, __builtin_amdgcn_exp2f((float)CLP * lg2gamma(h)), OB + ro * 2048 + h * 256, a.out + OUT_SRP + (size_t)((b * 8 + h) * 128) * 256, 256, tid);
    }
    volatile LAS int* qslot = (volatile LAS int*)(lds + MISC_OFF + 64);
    for (;;) {
        if (tid == 0) *qslot = (int)__hip_atomic_fetch_add((unsigned*)(ctl + CW_QUEUE), 1u, __ATOMIC_RELAXED, __HIP_MEMORY_SCOPE_AGENT);
        __syncthreads();
        const int it = *qslot;
        __syncthreads();
        if (it >= 2048 + 1024) break;
        if (it < 2048) { const int b = it >> 4, h = (it >> 2) & 3, vs = it & 3; const size_t r0 = MP + (size_t)b * 4; const size_t so = (size_t)((b * 4 + h) * 256) * 512 + vs * 128;
            stream_item<256, 128, 512>(lds, a.in[2] + so, a.out + OUT_SGS + so, QAT + r0 * 1024 + h * 256, KAT + r0 * 1024 + h * 256, KAH + r0 * 1024 + h * 256, BC + (r0 + 3) * 1024 + h * 256, 0.f,
                                       VA + r0 * 2048 + h * 512 + vs * 128, OA + r0 * 2048 + h * 512 + vs * 128, tid);
        } else { const int i = it - 2048, b = i >> 3, h = i & 7; const size_t r0 = MP + (size_t)b * 4; const size_t so = (size_t)((b * 8 + h) * 128) * 256;
            stream_item<128, 256, 256>(lds, a.in[3] + so, a.out + OUT_SRS + so, QBT + r0 * 1024 + h * 128, KBT + r0 * 1024 + h * 128, KBH + r0 * 1024 + h * 128, nullptr,
                                       __builtin_amdgcn_exp2f((float)CLS * lg2gamma(h)), VB + r0 * 2048 + h * 256, OB + r0 * 2048 + h * 256, tid);
        }
    }
}

__device__ __forceinline__ void phase4(const Args& a, int vcu, int G, int tid) {
    const int lane = tid & 63, wave = __builtin_amdgcn_readfirstlane(tid >> 6); unsigned char* ws = a.ws; const int gw = vcu * NWAVES + wave, NGW = G * NWAVES;
    const bf16* OA = (const bf16*)(ws + WS_OA); const bf16* OB = (const bf16*)(ws + WS_OB); const bf16* PA = (const bf16*)(ws + WS_PA); const bf16* PB = (const bf16*)(ws + WS_PB); bf16* MG = (bf16*)(ws + WS_MG);
    const float* gnw = a.in[7]; const float* rnw = a.in[8]; const float* rnb = a.in[9];
    const int c0 = 32 * lane;
    for (int m = gw; m < MT; m += NGW) {
        float oa[32], ob[32];
#pragma unroll
        for (int q = 0; q < 4; ++q) { const u32x4 wa = *(const u32x4*)(OA + (size_t)m * 2048 + c0 + 8 * q), wb = *(const u32x4*)(OB + (size_t)m * 2048 + c0 + 8 * q);
#pragma unroll
            for (int e = 0; e < 4; ++e) { oa[8 * q + 2 * e] = bflo(wa[e]); oa[8 * q + 2 * e + 1] = bfhi(wa[e]); ob[8 * q + 2 * e] = bflo(wb[e]); ob[8 * q + 2 * e + 1] = bfhi(wb[e]); } }
        float ssa = 0.f, sb = 0.f;
#pragma unroll
        for (int i = 0; i < 32; ++i) { ssa += oa[i] * oa[i]; sb += ob[i]; }
#pragma unroll
        for (int o = 1; o < 16; o <<= 1) ssa += __shfl_xor(ssa, o);
#pragma unroll
        for (int o = 1; o < 8; o <<= 1) sb += __shfl_xor(sb, o);
        const float rms = 1.0f / sqrtf(ssa * (1.f / 512.f) + HN_EPS), mean = sb * (1.f / 256.f);
        float qb = 0.f;
#pragma unroll
        for (int i = 0; i < 32; ++i) { ob[i] -= mean; qb += ob[i] * ob[i]; }
#pragma unroll
        for (int o = 1; o < 8; o <<= 1) qb += __shfl_xor(qb, o);
        const float rstd = 1.0f / sqrtf(qb * (1.f / 256.f) + HN_EPS);
#pragma unroll
        for (int q = 0; q < 4; ++q) { const u32x4 wa = *(const u32x4*)(PA + (size_t)m * 2048 + c0 + 8 * q), wb = *(const u32x4*)(PB + (size_t)m * 2048 + c0 + 8 * q); float o[8];
#pragma unroll
            for (int e = 0; e < 8; ++e) { const int i = 8 * q + e, c = c0 + i; const float pa = (e & 1) ? bfhi(wa[e >> 1]) : bflo(wa[e >> 1]), pb = (e & 1) ? bfhi(wb[e >> 1]) : bflo(wb[e >> 1]);
                o[e] = pa * (oa[i] * rms * gnw[c & 511]) + pb * (ob[i] * rstd * rnw[c] + rnb[c]); }
            u32x4 w; w.x = cvtpk(o[0], o[1]); w.y = cvtpk(o[2], o[3]); w.z = cvtpk(o[4], o[5]); w.w = cvtpk(o[6], o[7]);
            *(u32x4*)(MG + (size_t)m * 2048 + c0 + 8 * q) = w; }
    }
}

__device__ __forceinline__ void phase6(const Args& a, int vcu, int G, int tid) {
    const int lane = tid & 63, wave = __builtin_amdgcn_readfirstlane(tid >> 6); const int gw = vcu * NWAVES + wave, NGW = G * NWAVES;
    const float* lw = a.in[11]; const float* lb = a.in[12];
    for (int m = gw; m < MT; m += NGW) { f32x4* xr = (f32x4*)(a.out + (size_t)m * DM) + lane; f32x4 v[8]; float s = 0.f;
#pragma unroll
        for (int j = 0; j < 8; ++j) { v[j] = xr[64 * j]; s += (v[j][0] + v[j][1]) + (v[j][2] + v[j][3]); }
        const float mean = wave_sum(s) * (1.f / DM); float s2 = 0.f;
#pragma unroll
        for (int j = 0; j < 8; ++j) { v[j] = v[j] - mean; s2 += (v[j][0] * v[j][0] + v[j][1] * v[j][1]) + (v[j][2] * v[j][2] + v[j][3] * v[j][3]); }
        const float rstd = 1.0f / sqrtf(wave_sum(s2) * (1.f / DM) + LN_EPS);
#pragma unroll
        for (int j = 0; j < 8; ++j) { const f32x4 w = *((const f32x4*)lw + lane + 64 * j), bb = *((const f32x4*)lb + lane + 64 * j); xr[64 * j] = v[j] * rstd * w + bb; } }
}

__global__ void __launch_bounds__(NT, 2) mega_fwd(Args a) {
    extern __shared__ __attribute__((aligned(16))) unsigned char lds_raw[];
    LAS unsigned char* lds = (LAS unsigned char*)lds_raw;
    const int tid = threadIdx.x;
    const int G = gridDim.x; const int bx = blockIdx.x; const int vcu = (G % 8 == 0) ? (bx % 8) * (G / 8) + bx / 8 : bx;
    volatile LAS unsigned* MISC = (volatile LAS unsigned*)(lds + MISC_OFF);
    if (tid < 64) MISC[tid] = 0u;
    __syncthreads();
    gu32* ctl = (gu32*)(a.ws + WS_CTL);
    const int lo = a.ph_lo, hi = a.ph_hi;
    XcdBarrier bar; bar.bar = (unsigned*)(ctl + CW_BAR); bar.x = 0; bar.st = nullptr;
    if (hi - lo > 1) bar = xcd_barrier_post((unsigned*)(ctl + CW_BAR), MISC + 8);
#define IN(k) (lo <= (k) && (k) < hi)
#define SEAM(k) do { if (IN(k) && IN((k) + 1)) xcd_barrier(bar); } while (0)
    unsigned char* ws = a.ws;
    if (IN(0)) { phase0(a, lds, vcu, G, tid); }
    SEAM(0);
    if (IN(1)) {
        pg8::Gemm g{(const pg8::bf16_t*)(ws + WS_XB), (const pg8::bf16_t*)(ws + WS_W1T), MT, N1, DM}; pg8::StaticOrder S; S.init(MT, N1, G, bx);
        EpiG1 E{(bf16*)(ws + WS_QAT), (bf16*)(ws + WS_KAT), (bf16*)(ws + WS_KAH), (bf16*)(ws + WS_VA), (bf16*)(ws + WS_QBT), (bf16*)(ws + WS_KBT), (bf16*)(ws + WS_KBH), (bf16*)(ws + WS_VB),
                (bf16*)(ws + WS_PA), (bf16*)(ws + WS_PB), (const float*)(ws + WS_BC), (const float*)(ws + WS_RT)};
        pg8::gemm_phase<EpiG1, pg8::StaticOrder, true, true>(lds, g, S, E);
    }
    SEAM(1);
    if (IN(2)) { phase2(a, vcu, G, tid); }
    SEAM(2);
    if (IN(3)) { phase3(a, lds, ctl, tid); }
    SEAM(3);
    if (IN(4)) { phase4(a, vcu, G, tid); }
    SEAM(4);
    if (IN(5)) {
        pg8::Gemm g{(const pg8::bf16_t*)(ws + WS_MG), (const pg8::bf16_t*)(ws + WS_W2T), MT, DM, DM}; pg8::StaticOrder S; S.init(MT, DM, G, bx);
        EpiG2 E{a.in[0], a.in[1], a.out + OUT_Y};
        pg8::gemm_phase<EpiG2, pg8::StaticOrder, true, true>(lds, g, S, E);
    }
    SEAM(5);
    if (IN(6)) { phase6(a, vcu, G, tid); }
#undef IN
#undef SEAM
}

extern "C" void kernel_launch(void* const* d_in, const int* in_sizes, int n_in, void* d_out, int out_size, void* d_ws, size_t ws_size, hipStream_t stream) {
    static int grid = 0;
    if (grid == 0) {
        if (n_in != 13 || in_sizes[0] != MP * DM || in_sizes[1] != MS * DM || (size_t)out_size != OUT_TOTAL || ws_size < WS_END) {
            fprintf(stderr, "kernel_launch: unexpected shapes (n_in %d, in0 %d, in1 %d, out %d, ws %zu); nothing launched\n", n_in, n_in > 0 ? in_sizes[0] : -1, n_in > 1 ? in_sizes[1] : -1, out_size, ws_size); grid = -1; return; }
        int dev = 0, cus = 0, per_cu = 0;
        if (hipGetDevice(&dev) != hipSuccess || hipDeviceGetAttribute(&cus, hipDeviceAttributeMultiprocessorCount, dev) != hipSuccess) { fprintf(stderr, "kernel_launch: device query failed\n"); grid = -1; return; }
        if (hipFuncSetAttribute((const void*)mega_fwd, hipFuncAttributeMaxDynamicSharedMemorySize, LDS_BYTES) != hipSuccess) { fprintf(stderr, "kernel_launch: hipFuncSetAttribute failed\n"); grid = -1; return; }
        if (hipOccupancyMaxActiveBlocksPerMultiprocessor(&per_cu, (const void*)mega_fwd, NT, LDS_BYTES) != hipSuccess || per_cu < 1) { fprintf(stderr, "kernel_launch: occupancy query says %d workgroups per CU\n", per_cu); (void)hipGetLastError(); grid = -1; return; }
        grid = cus;
        if (grid < 96 || grid % 8 != 0) { fprintf(stderr, "kernel_launch: %d CUs unsupported\n", grid); grid = -1; return; }
    }
    if (grid < 0) return;
    if (hipMemsetAsync((char*)d_ws + WS_CTL, 0, CTL_ZERO_BYTES, stream) != hipSuccess) { fprintf(stderr, "kernel_launch: memset failed\n"); return; }
    Args a{};
    for (int i = 0; i < 13; ++i) a.in[i] = (const float*)d_in[i];
    a.out = (float*)d_out; a.ws = (unsigned char*)d_ws;
    if (MK_N_LAUNCHES == 1) { a.ph_lo = 0; a.ph_hi = N_PHASES; hipLaunchKernelGGL(mega_fwd, dim3(grid), dim3(NT), LDS_BYTES, stream, a); }
    else { for (int p = 0; p < N_PHASES; ++p) { a.ph_lo = p; a.ph_hi = p + 1; hipLaunchKernelGGL(mega_fwd, dim3(grid), dim3(NT), LDS_BYTES, stream, a); } }
    const hipError_t le = hipPeekAtLastError();
    if (le != hipSuccess) fprintf(stderr, "kernel_launch: launch failed: %s\n", hipGetErrorName(le));
}
```

```cpp
#include <hip/hip_runtime.h>
#include <cstdio>
#include <cstdint>
#define MK_N_LAUNCHES 1
#define REP_PHASE -1
namespace pg8 {
#define PG8_LAS __attribute__((address_space(3)))
typedef unsigned short bf16_t;
typedef short bf16x8 __attribute__((ext_vector_type(8)));
typedef float f32x4 __attribute__((ext_vector_type(4)));
typedef unsigned u32x4 __attribute__((ext_vector_type(4)));
constexpr int BM = 256, BK = 64, HALF = 128, HTB = HALF * BK * 2  , STAGE_BYTES = 8 * HTB, NXCD = 8, WGM = 8;

__host__ __device__ __forceinline__ int lds_byte(int r, int c) { const int st = (r >> 4) * 2 + (c >> 5), rr = r & 15, cc = c & 31, ob = rr * 64 + cc * 2; return st * 1024 + (ob ^ (((ob >> 9) & 1) << 5)); }
__host__ __device__ __forceinline__ void stage_rc(int b, int& R, int& C) { const int st = b / 1024, sb = b % 1024, swz = sb ^ (((sb >> 9) & 1) << 5); R = (st >> 1) * 16 + swz / 64; C = (st & 1) * 32 + (swz % 64) / 2; }
__host__ __device__ __forceinline__ int perm32(int rho) { const int n = rho >> 4, i = rho & 15; return 8 * (i >> 2) + 4 * n + (i & 3); }

struct Unit { int pm, pn; };
struct Gemm { const bf16_t* A; const bf16_t* Bt; int M, N, K; };

struct StaticOrder {
    int nM, nN, nwg, G, c;
    __host__ __device__ void init(int M, int N, int G_, int c_) { nM = M / BM; nN = N / BM; nwg = nM * nN; G = G_; c = c_; }
    __host__ __device__ bool next(int i, Unit& u) const {
        const long L = (long)i * G + c; if (L >= nwg) return false;
        int wgid = (int)L; { const int q = nwg / NXCD, r = nwg % NXCD, xcd = wgid % NXCD, off = wgid / NXCD; wgid = (xcd < r ? xcd * (q + 1) : r * (q + 1) + (xcd - r) * q) + off; }
        const int nig = WGM * nN, gid = wgid / nig, fm = gid * WGM, gsz = (nM - fm) < WGM ? (nM - fm) : WGM;
        u.pm = fm + ((wgid % nig) % gsz); u.pn = (wgid % nig) / gsz; return true;
    }
    __device__ __forceinline__ void a_ready(const Unit&) const {}
    __device__ __forceinline__ void done(const Unit&) const {}
};

template <class Epi, class Sched, bool ALIGN_EPI = false, bool SP2 = false>
__device__ __forceinline__ void gemm_phase(PG8_LAS unsigned char* lds, const Gemm g, const Sched& S, const Epi& E) {
    const int tid = threadIdx.x, wid = __builtin_amdgcn_readfirstlane(tid >> 6), lane = tid & 63, wr = wid >> 2, wc = wid & 3, fr = lane & 15, fq = lane >> 4;
    const int K = g.K, nt = K / BK;
    unsigned voffA[2], voffB[2];
#pragma unroll
    for (int i = 0; i < 2; ++i) { int R, C; stage_rc(tid * 16 + i * 8192, R, C); const int Rb = Epi::PERM ? ((R & ~31) + perm32(R & 31)) : R;
        voffA[i] = (unsigned)(R * K + C) * 2u; voffB[i] = (unsigned)(Rb * K + C) * 2u; }
    const size_t kstep = (size_t)(BK * 2);
    const size_t hstep = (size_t)HALF * K * 2;
    const size_t tstep = 2 * hstep;
    const unsigned ldsw = (unsigned)wid * 1024u;
    const int aoff = lds_byte(wr * 64 + fr, fq * 8), boff = lds_byte(wc * 32 + fr, fq * 8);
#define PG8_SA(b, h) (((b) * 2 + (h)) * HTB)
#define PG8_SB(b, h) ((4 + (b) * 2 + (h)) * HTB)
#define PG8_STAGE(bufoff, gbase, voff) do { _Pragma("unroll") for (int _i = 0; _i < 2; ++_i) \
        __builtin_amdgcn_global_load_lds((const unsigned*)((const char*)(gbase) + (voff)[_i]), (PG8_LAS unsigned*)(lds + (bufoff) + ldsw + _i * 8192), 16, 0, 0); } while (0)
#define PG8_LDA(dst, b, h) do { _Pragma("unroll") for (int m = 0; m < 4; ++m) _Pragma("unroll") for (int k = 0; k < 2; ++k) dst[m][k] = *(const PG8_LAS bf16x8*)(lds + PG8_SA(b, h) + aoff + m * 2048 + k * 1024); } while (0)
#define PG8_LDB(dst, b, h) do { _Pragma("unroll") for (int n = 0; n < 2; ++n) _Pragma("unroll") for (int k = 0; k < 2; ++k) dst[n][k] = *(const PG8_LAS bf16x8*)(lds + PG8_SB(b, h) + boff + n * 2048 + k * 1024); } while (0)
#define PG8_MMA(ai, bj, At, Bt) do { __builtin_amdgcn_s_setprio(1); _Pragma("unroll") for (int m = 0; m < 4; ++m) _Pragma("unroll") for (int n = 0; n < 2; ++n) _Pragma("unroll") for (int k = 0; k < 2; ++k) \
        acc[ai][bj][m][n] = __builtin_amdgcn_mfma_f32_16x16x32_bf16(Bt[n][k], At[m][k], acc[ai][bj][m][n], 0, 0, 0); __builtin_amdgcn_s_setprio(0); } while (0)
#define PG8_WAIT_V(n) asm volatile("s_waitcnt vmcnt(" #n ")" ::: "memory")
#define PG8_WAIT_L(n) asm volatile("s_waitcnt lgkmcnt(" #n ")" ::: "memory")
#define PG8_BAR __builtin_amdgcn_s_barrier()
#define PG8_SCHED __builtin_amdgcn_sched_barrier(0)
    Unit cur, nxt; int ui = 0;
    if (!S.next(0, cur)) return;
    f32x4 acc[2][2][4][2];
#pragma unroll
    for (int a = 0; a < 2; ++a)
#pragma unroll
        for (int b = 0; b < 2; ++b)
#pragma unroll
            for (int m = 0; m < 4; ++m)
#pragma unroll
                for (int n = 0; n < 2; ++n) acc[a][b][m][n] = (f32x4){0.f, 0.f, 0.f, 0.f};
    bf16x8 At[4][2], B0[2][2], B1[2][2];
    const char* cA = (const char*)g.A + (size_t)cur.pm * tstep; const char* cB = (const char*)g.Bt + (size_t)cur.pn * tstep;
    S.a_ready(cur);
    if constexpr (SP2) {
        PG8_STAGE(PG8_SB(0, 0), cB, voffB); PG8_STAGE(PG8_SB(0, 1), cB + hstep, voffB); PG8_STAGE(PG8_SA(0, 0), cA, voffA); PG8_STAGE(PG8_SA(0, 1), cA + hstep, voffA);
        if (wr == 1) PG8_BAR;
        PG8_WAIT_V(2); PG8_BAR;
        PG8_STAGE(PG8_SB(1, 0), cB + kstep, voffB); PG8_STAGE(PG8_SA(1, 0), cA + kstep, voffA); PG8_STAGE(PG8_SB(1, 1), cB + hstep + kstep, voffB);
        PG8_WAIT_V(6); PG8_BAR;
    } else {
        PG8_STAGE(PG8_SB(0, 0), cB, voffB); PG8_STAGE(PG8_SA(0, 0), cA, voffA); PG8_STAGE(PG8_SB(0, 1), cB + hstep, voffB); PG8_STAGE(PG8_SA(0, 1), cA + hstep, voffA);
        if (wr == 1) PG8_BAR;
        PG8_WAIT_V(4); PG8_BAR;
        PG8_STAGE(PG8_SB(1, 0), cB + kstep, voffB); PG8_STAGE(PG8_SA(1, 0), cA + kstep, voffA); PG8_STAGE(PG8_SB(1, 1), cB + hstep + kstep, voffB);
        PG8_WAIT_V(6); PG8_BAR;
    }
    for (;;) {
        const bool has_next = S.next(ui + 1, nxt);
        const char* nA = has_next ? (const char*)g.A + (size_t)nxt.pm * tstep : cA; const char* nB = has_next ? (const char*)g.Bt + (size_t)nxt.pn * tstep : cB;
        for (int t = 0; t < nt; t += 2) {
            const bool last = (t == nt - 2);
            const char* a1 = cA + (size_t)(t + 1) * kstep;
            const char* a2 = last ? nA : cA + (size_t)(t + 2) * kstep; const char* b2 = last ? nB : cB + (size_t)(t + 2) * kstep;
            const char* a3 = a2 + kstep; const char* b3 = b2 + kstep;
            if (last && has_next) S.a_ready(nxt);
            if constexpr (SP2) {
            PG8_LDB(B0, 0, 0); PG8_LDB(B1, 0, 1); PG8_SCHED; PG8_LDA(At, 0, 0); PG8_STAGE(PG8_SA(1, 1), a1 + hstep, voffA);
            PG8_WAIT_V(8); PG8_WAIT_L(0); PG8_BAR; PG8_MMA(0, 0, At, B0); PG8_MMA(0, 1, At, B1); PG8_BAR; PG8_SCHED;
            PG8_LDA(At, 0, 1); PG8_STAGE(PG8_SB(0, 0), b2, voffB); PG8_STAGE(PG8_SB(0, 1), b2 + hstep, voffB); PG8_STAGE(PG8_SA(0, 0), a2, voffA);
            PG8_WAIT_V(8); PG8_WAIT_L(0); PG8_BAR; PG8_MMA(1, 0, At, B0); PG8_MMA(1, 1, At, B1); PG8_BAR; PG8_SCHED;
            PG8_LDB(B0, 1, 0); PG8_LDB(B1, 1, 1); PG8_SCHED; PG8_LDA(At, 1, 0); PG8_STAGE(PG8_SA(0, 1), a2 + hstep, voffA);
            PG8_WAIT_V(8); PG8_WAIT_L(0); PG8_BAR; PG8_MMA(0, 0, At, B0); PG8_MMA(0, 1, At, B1); PG8_BAR; PG8_SCHED;
            PG8_LDA(At, 1, 1); PG8_STAGE(PG8_SB(1, 0), b3, voffB); PG8_STAGE(PG8_SB(1, 1), b3 + hstep, voffB); PG8_STAGE(PG8_SA(1, 0), a3, voffA);
            PG8_WAIT_V(8); PG8_WAIT_L(0); PG8_BAR; PG8_MMA(1, 0, At, B0); PG8_MMA(1, 1, At, B1); PG8_BAR; PG8_SCHED;
            } else {
            PG8_LDB(B0, 0, 0); PG8_SCHED; PG8_LDA(At, 0, 0); PG8_STAGE(PG8_SA(1, 1), a1 + hstep, voffA);
            PG8_WAIT_L(8); PG8_BAR; PG8_WAIT_L(0); PG8_MMA(0, 0, At, B0); PG8_BAR; PG8_SCHED;
            PG8_LDB(B1, 0, 1); PG8_STAGE(PG8_SB(0, 0), b2, voffB);
            PG8_BAR; PG8_WAIT_L(0); PG8_MMA(0, 1, At, B1); PG8_BAR;
            PG8_LDA(At, 0, 1); PG8_STAGE(PG8_SA(0, 0), a2, voffA);
            PG8_BAR; PG8_WAIT_L(0); PG8_MMA(1, 0, At, B0); PG8_BAR; PG8_SCHED;
            PG8_STAGE(PG8_SB(0, 1), b2 + hstep, voffB);
            PG8_WAIT_V(6); PG8_BAR; PG8_MMA(1, 1, At, B1); PG8_BAR;
            PG8_LDB(B0, 1, 0); PG8_SCHED; PG8_LDA(At, 1, 0); PG8_STAGE(PG8_SA(0, 1), a2 + hstep, voffA);
            PG8_WAIT_L(8); PG8_BAR; PG8_WAIT_L(0); PG8_MMA(0, 0, At, B0); PG8_BAR; PG8_SCHED;
            PG8_LDB(B1, 1, 1); PG8_STAGE(PG8_SB(1, 0), b3, voffB);
            PG8_BAR; PG8_WAIT_L(0); PG8_MMA(0, 1, At, B1); PG8_BAR;
            PG8_LDA(At, 1, 1); PG8_STAGE(PG8_SA(1, 0), a3, voffA);
            PG8_BAR; PG8_WAIT_L(0); PG8_MMA(1, 0, At, B0); PG8_BAR; PG8_SCHED;
            PG8_STAGE(PG8_SB(1, 1), b3 + hstep, voffB);
            PG8_WAIT_V(6); PG8_BAR; PG8_MMA(1, 1, At, B1); PG8_BAR;
            }
        }
        if constexpr (ALIGN_EPI) { if (wr == 0) PG8_BAR; }
        if constexpr (!Epi::AFTER_DRAIN) { E(acc, cur, wr, wc, fr, fq); S.done(cur); }
        if (!has_next) break;
#pragma unroll
        for (int a = 0; a < 2; ++a)
#pragma unroll
            for (int b = 0; b < 2; ++b)
#pragma unroll
                for (int m = 0; m < 4; ++m)
#pragma unroll
                    for (int n = 0; n < 2; ++n) acc[a][b][m][n] = (f32x4){0.f, 0.f, 0.f, 0.f};
        cur = nxt; cA = nA; cB = nB; ++ui;
        if constexpr (ALIGN_EPI) { if (wr == 1) PG8_BAR; }
    }
    PG8_WAIT_V(0);
    if constexpr (!ALIGN_EPI) { if (wr == 0) PG8_BAR; }
    PG8_BAR;
    if constexpr (Epi::AFTER_DRAIN) { E.fused(acc, cur, wr, wc, fr, fq, lds, wid, lane); S.done(cur); }
#undef PG8_SA
#undef PG8_SB
#undef PG8_STAGE
#undef PG8_LDA
#undef PG8_LDB
#undef PG8_MMA
#undef PG8_WAIT_V
#undef PG8_WAIT_L
#undef PG8_BAR
#undef PG8_SCHED
}
}
#define LAS __attribute__((address_space(3)))
#define XB_TMO      128
#define XB_XCNT(j)  (256  + 64 * (j))
#define XB_XSUB(j)  (1280 + 64 * (j))
#define XB_XGEN(j)  (2304 + 64 * (j))
#define XB_TOP      3328
#define XB_TOPGEN   3392
#define XCD_BAR_WORDS 3456
#define XB_SPIN_CAP (1u << 18)

__device__ __forceinline__ unsigned xb_ld(unsigned* p)              { return __hip_atomic_load(p, __ATOMIC_RELAXED, __HIP_MEMORY_SCOPE_AGENT); }
__device__ __forceinline__ unsigned xb_add(unsigned* p, unsigned v) { return __hip_atomic_fetch_add(p, v, __ATOMIC_RELAXED, __HIP_MEMORY_SCOPE_AGENT); }
__device__ __forceinline__ unsigned xb_xcc_id() { return (unsigned)__builtin_amdgcn_s_getreg((3 << 11) | 20) & 0xFu; }
#define XB_SPIN(cond, bar) do { unsigned _sp = 0; while (cond) { __builtin_amdgcn_s_sleep(1); \
    if ((++_sp & 255u) == 0u) { if (xb_ld(&(bar)[XB_TMO])) break; if (_sp > XB_SPIN_CAP) { atomicAdd(&(bar)[XB_TMO], 1u); break; } } } } while (0)

struct XcdBarrier {
    unsigned* bar; unsigned x;
    volatile LAS unsigned* st;
};

__device__ __forceinline__ XcdBarrier xcd_barrier_post(unsigned* bar, volatile LAS unsigned* st) {
    XcdBarrier b; b.bar = bar; b.x = xb_xcc_id(); b.st = st;
    if (threadIdx.x == 0) (void)xb_add(&bar[XB_XCNT(b.x)], 1u);
    return b;
}
__device__ __forceinline__ void xcd_barrier_complete(unsigned* bar, unsigned x, unsigned& nloc, unsigned& nx) {
    const unsigned G = gridDim.x * gridDim.y * gridDim.z;
    unsigned sum, cnt, mine, sp = 0u;
    for (;;) {
        sum = 0u; cnt = 0u; mine = 0u;
#pragma unroll
        for (unsigned j = 0; j < 16; ++j) { const unsigned c = xb_ld(&bar[XB_XCNT(j)]); sum += c; cnt += (c > 0u) ? 1u : 0u; mine = (j == x) ? c : mine; }
        if (sum == G) break;
        __builtin_amdgcn_s_sleep(1);
        if ((++sp & 255u) == 0u) { if (xb_ld(&bar[XB_TMO])) break; if (sp > XB_SPIN_CAP) { atomicAdd(&bar[XB_TMO], 1u); break; } }
    }
    nloc = mine > 0u ? mine : 1u; nx = cnt > 0u ? cnt : 1u;
}

__device__ __forceinline__ void xcd_barrier(const XcdBarrier& b) {
    asm volatile("s_waitcnt vmcnt(0)" ::: "memory");
    __syncthreads();
    if (threadIdx.x == 0) {
        unsigned* bar = b.bar;
        __builtin_amdgcn_s_waitcnt(0);
        unsigned nloc = b.st[0], nx = b.st[1];
        if (nloc == 0u) { xcd_barrier_complete(bar, b.x, nloc, nx); b.st[0] = nloc; b.st[1] = nx; }
        const unsigned old = xb_add(&bar[XB_XSUB(b.x)], 1u);
        const unsigned gen = old / nloc;
        if (old + 1u == (gen + 1u) * nloc) {
            __builtin_amdgcn_fence(__ATOMIC_RELEASE, "agent");
            asm volatile("s_waitcnt vmcnt(0)" ::: "memory");
            const unsigned og = xb_add(&bar[XB_TOP], 1u);
            const unsigned tg = og / nx;
            if (og + 1u == (tg + 1u) * nx) xb_add(&bar[XB_TOPGEN], 1u);
            else XB_SPIN(xb_ld(&bar[XB_TOPGEN]) == tg, bar);
            __builtin_amdgcn_fence(__ATOMIC_ACQUIRE, "agent");
            xb_add(&bar[XB_XGEN(b.x)], 1u);
            asm volatile("s_waitcnt vmcnt(0)" ::: "memory");
        } else {
            XB_SPIN(xb_ld(&bar[XB_XGEN(b.x)]) == gen, bar);
            __builtin_amdgcn_fence(__ATOMIC_ACQUIRE, "agent");
            asm volatile("s_waitcnt vmcnt(0)" ::: "memory");
        }
    }
    __syncthreads();
}

#define GAS __attribute__((address_space(1)))
#define LAS __attribute__((address_space(3)))
typedef unsigned short bf16;
typedef float f32x4 __attribute__((ext_vector_type(4)));
typedef float f32x2 __attribute__((ext_vector_type(2)));
typedef float f32x16 __attribute__((ext_vector_type(16)));
typedef unsigned u32x4 __attribute__((ext_vector_type(4)));
typedef unsigned u32x2 __attribute__((ext_vector_type(2)));
typedef short bf16x8 __attribute__((ext_vector_type(8)));
typedef short s16x4 __attribute__((ext_vector_type(4)));
typedef __bf16 bf16x2_t __attribute__((ext_vector_type(2)));
typedef GAS unsigned gu32;

constexpr int NT = 512, NWAVES = 8;
constexpr int DM = 2048, MP = 8192, MS = 512, MT = MP + MS;
constexpr int NIN = 16400, N1 = 16384;
constexpr int CLP = 32, CLS = 4;
constexpr int NCH = 2048 / CLP;
constexpr float LN_EPS = 1e-5f, HN_EPS = 1e-6f;
constexpr float DN_ALPHA = 1.189207115002721f;
constexpr float RET_KS = 0.08838834764831845f;
constexpr size_t MiB = 1u << 20;
constexpr size_t WS_CTL = 0, CTL_ZERO_BYTES = 1 * MiB;
constexpr size_t WS_W1T = 2 * MiB;
constexpr size_t WS_W2T = 66 * MiB;
constexpr size_t WS_XB  = 74 * MiB;
constexpr size_t WS_BC  = 108 * MiB;
constexpr size_t WS_RT  = 142 * MiB;
constexpr size_t WS_QAT = 144 * MiB;
constexpr size_t WS_KAT = 161 * MiB, WS_KAH = 178 * MiB;
constexpr size_t WS_VA  = 195 * MiB;
constexpr size_t WS_QBT = 229 * MiB, WS_KBT = 246 * MiB, WS_KBH = 263 * MiB;
constexpr size_t WS_VB  = 280 * MiB;
constexpr size_t WS_PA  = 314 * MiB, WS_PB = 348 * MiB;
constexpr size_t WS_PG  = 382 * MiB;
constexpr size_t WS_PR  = 384 * MiB;
constexpr size_t WS_OA  = 388 * MiB, WS_OB = 422 * MiB, WS_MG = 456 * MiB;
constexpr size_t WS_END = 490 * MiB;
constexpr size_t OUT_Y = 0, OUT_SGP = 17825792, OUT_SRP = 19922944, OUT_SGS = 20971520, OUT_SRS = 88080384, OUT_TOTAL = 121634816;
constexpr int CW_QUEUE = 64;
constexpr int CW_BAR = 4096;
constexpr int LDS_BYTES = 160 * 1024;
constexpr int MISC_OFF = LDS_BYTES - 256;

#ifndef MK_N_LAUNCHES
#define MK_N_LAUNCHES 1
#endif
constexpr int N_PHASES = 7;

#define LDS_WAIT() asm volatile("s_waitcnt lgkmcnt(0)" ::: "memory")
#define VM_WAIT() asm volatile("s_waitcnt vmcnt(0)" ::: "memory")
__device__ __forceinline__ unsigned cvtpk(float lo, float hi) { f32x2 v = {lo, hi}; bf16x2_t b = __builtin_convertvector(v, bf16x2_t); return __builtin_bit_cast(unsigned, b); }
__device__ __forceinline__ float bf2f(unsigned short b) { return __builtin_bit_cast(float, (unsigned)b << 16); }
__device__ __forceinline__ float bflo(unsigned w) { return __builtin_bit_cast(float, w << 16); }
__device__ __forceinline__ float bfhi(unsigned w) { return __builtin_bit_cast(float, w & 0xffff0000u); }
__device__ __forceinline__ u32x4 pk8(f32x4 a, f32x4 b) { u32x4 w; w.x = cvtpk(a[0], a[1]); w.y = cvtpk(a[2], a[3]); w.z = cvtpk(b[0], b[1]); w.w = cvtpk(b[2], b[3]); return w; }
__device__ __forceinline__ float wave_sum(float v) {
#pragma unroll
    for (int o = 1; o < 64; o <<= 1) v += __shfl_xor(v, o);
    return v;
}
__device__ __forceinline__ s16x4 vtr(LAS unsigned char* p) { typedef short v4i16_t __attribute__((ext_vector_type(4))); return __builtin_bit_cast(s16x4, __builtin_amdgcn_ds_read_tr16_b64_v4i16((LAS v4i16_t*)p)); }
#define MFMA32(a, b, c) __builtin_amdgcn_mfma_f32_32x32x16_bf16((a), (b), (c), 0, 0, 0)
__device__ __forceinline__ int crow(int reg, int h) { return (reg & 3) + 8 * (reg >> 2) + 4 * h; }
__device__ __forceinline__ float lg2gamma(int h) {
    const float t[8] = {-0.045803689613124789f, -0.022720076500083529f, -0.011315313227834146f, -0.0056465631411420627f, -0.0028205190623786626f, -0.0014095702546713536f, -0.00070461297658937271f, -0.00035226347162902138f};
    float r = t[0];
#pragma unroll
    for (int i = 1; i < 8; ++i) r = (h == i) ? t[i] : r;
    return r;
}

struct EpiG1 {
    static constexpr bool PERM = true, AFTER_DRAIN = false;
    bf16 *QAT, *KAT, *KAH, *VA, *QBT, *KBT, *KBH, *VB, *PA, *PB; const float* BC; const float* RT;
    __device__ __forceinline__ void operator()(const f32x4 (&acc)[2][2][4][2], const pg8::Unit& u, int wr, int wc, int fr, int fq) const {
        const int pn = u.pn, rbase = u.pm * 256 + wr * 64 + fr, cq = wc * 32 + 8 * fq;
        if (pn < 4) {
#pragma unroll
            for (int ai = 0; ai < 2; ++ai)
#pragma unroll
                for (int m = 0; m < 4; ++m) { const int r = rbase + ai * 128 + m * 16;
#pragma unroll
                    for (int bj = 0; bj < 2; ++bj) { const size_t o = (size_t)r * 1024 + pn * 256 + bj * 128 + cq;
                        const f32x4 b0 = *(const f32x4*)(BC + o), b1 = *(const f32x4*)(BC + o + 4); f32x4 v0 = acc[ai][bj][m][0], v1 = acc[ai][bj][m][1];
#pragma unroll
                        for (int j = 0; j < 4; ++j) { v0[j] *= 0.0625f * __expf(b0[j]); v1[j] *= 0.0625f * __expf(b1[j]); }
                        *(u32x4*)(QAT + o) = pk8(v0, v1); } }
        } else if (pn < 8) {
#pragma unroll
            for (int ai = 0; ai < 2; ++ai)
#pragma unroll
                for (int m = 0; m < 4; ++m) { const int r = rbase + ai * 128 + m * 16; const int rl = r < MP ? (r | (CLP - 1)) : (r | (CLS - 1));
#pragma unroll
                    for (int bj = 0; bj < 2; ++bj) { const int col = (pn - 4) * 256 + bj * 128 + cq; const size_t o = (size_t)r * 1024 + col, ol = (size_t)rl * 1024 + col;
                        const f32x4 b0 = *(const f32x4*)(BC + o), b1 = *(const f32x4*)(BC + o + 4), l0 = *(const f32x4*)(BC + ol), l1 = *(const f32x4*)(BC + ol + 4);
                        const f32x4 a0 = acc[ai][bj][m][0], a1 = acc[ai][bj][m][1]; f32x4 t0, t1, h0, h1;
#pragma unroll
                        for (int j = 0; j < 4; ++j) { t0[j] = a0[j] * __expf(-b0[j]); t1[j] = a1[j] * __expf(-b1[j]); h0[j] = a0[j] * __expf(l0[j] - b0[j]); h1[j] = a1[j] * __expf(l1[j] - b1[j]); }
                        *(u32x4*)(KAT + o) = pk8(t0, t1); *(u32x4*)(KAH + o) = pk8(h0, h1); } }
        } else if (pn < 16 || (pn >= 24 && pn < 32)) {
            bf16* V = pn < 16 ? VA : VB; const int ct = (pn < 16 ? pn - 8 : pn - 24) * 256;
#pragma unroll
            for (int ai = 0; ai < 2; ++ai)
#pragma unroll
                for (int m = 0; m < 4; ++m) { const int r = rbase + ai * 128 + m * 16;
#pragma unroll
                    for (int bj = 0; bj < 2; ++bj) *(u32x4*)(V + (size_t)r * 2048 + ct + bj * 128 + cq) = pk8(acc[ai][bj][m][0], acc[ai][bj][m][1]); }
        } else if (pn < 24) {
            const bool isq = pn < 20; const int hp = (pn & 3) * 2;
#pragma unroll
            for (int ai = 0; ai < 2; ++ai)
#pragma unroll
                for (int m = 0; m < 4; ++m) { const int r = rbase + ai * 128 + m * 16; const bool pr = r < MP;
                    const int ridx = pr ? (r & 2047) : 2048 + (r & 3), ic = pr ? (r & (CLP - 1)) : (r & (CLS - 1)), cl = pr ? CLP : CLS;
                    const float* rt = RT + ((size_t)ridx * 64 + 16 * wc + 4 * fq) * 2;
                    const f32x4 ta = *(const f32x4*)rt, tb = *(const f32x4*)(rt + 4);
#pragma unroll
                    for (int bj = 0; bj < 2; ++bj) { const int head = hp + bj; const float lg = lg2gamma(head);
                        const f32x4 a0 = acc[ai][bj][m][0], a1 = acc[ai][bj][m][1]; f32x4 y0, y1;
                        y0[0] = a0[0] * ta[0] - a0[1] * ta[1]; y0[1] = a0[1] * ta[0] + a0[0] * ta[1]; y0[2] = a0[2] * ta[2] - a0[3] * ta[3]; y0[3] = a0[3] * ta[2] + a0[2] * ta[3];
                        y1[0] = a1[0] * tb[0] - a1[1] * tb[1]; y1[1] = a1[1] * tb[0] + a1[0] * tb[1]; y1[2] = a1[2] * tb[2] - a1[3] * tb[3]; y1[3] = a1[3] * tb[2] + a1[2] * tb[3];
                        const size_t o = (size_t)r * 1024 + head * 128 + cq;
                        if (isq) { const float sc = __builtin_amdgcn_exp2f((float)(ic + 1) * lg); *(u32x4*)(QBT + o) = pk8(y0 * sc, y1 * sc); }
                        else { const float st = RET_KS * __builtin_amdgcn_exp2f(-(float)(ic + 1) * lg), sh = RET_KS * __builtin_amdgcn_exp2f((float)(cl - 1 - ic) * lg);
                            *(u32x4*)(KBT + o) = pk8(y0 * st, y1 * st); *(u32x4*)(KBH + o) = pk8(y0 * sh, y1 * sh); } } }
        } else {
            bf16* P = pn < 48 ? PA : PB; const int ct = (pn < 48 ? pn - 32 : pn - 48) * 128;
#pragma unroll
            for (int ai = 0; ai < 2; ++ai)
#pragma unroll
                for (int m = 0; m < 4; ++m) { const int r = rbase + ai * 128 + m * 16; f32x4 p0, p1;
#pragma unroll
                    for (int j = 0; j < 4; ++j) { const float z0 = acc[ai][0][m][0][j], g0 = acc[ai][1][m][0][j], z1 = acc[ai][0][m][1][j], g1 = acc[ai][1][m][1][j];
                        p0[j] = z0 * __builtin_amdgcn_rcpf((1.f + __expf(-z0)) * (1.f + __expf(-g0))); p1[j] = z1 * __builtin_amdgcn_rcpf((1.f + __expf(-z1)) * (1.f + __expf(-g1))); }
                    *(u32x4*)(P + (size_t)r * 2048 + ct + cq) = pk8(p0, p1); }
        }
    }
};
struct EpiG2 {
    static constexpr bool PERM = false, AFTER_DRAIN = false;
    const float* xp; const float* xs; float* out;
    __device__ __forceinline__ void operator()(const f32x4 (&acc)[2][2][4][2], const pg8::Unit& u, int wr, int wc, int fr, int fq) const {
        const int row0 = u.pm * 256 + wr * 64 + fr, col0 = u.pn * 256 + wc * 32 + 4 * fq;
#pragma unroll
        for (int ai = 0; ai < 2; ++ai)
#pragma unroll
            for (int m = 0; m < 4; ++m) { const int r = row0 + ai * 128 + m * 16; const float* xr = (r < MP ? xp + (size_t)r * DM : xs + (size_t)(r - MP) * DM) + col0; float* orow = out + (size_t)r * DM + col0;
#pragma unroll
                for (int bj = 0; bj < 2; ++bj)
#pragma unroll
                    for (int n = 0; n < 2; ++n) { const f32x4 xv = *(const f32x4*)(xr + bj * 128 + n * 16); *(f32x4*)(orow + bj * 128 + n * 16) = xv * DN_ALPHA + acc[ai][bj][m][n]; } }
    }
};

struct Args { const float* in[13]; float* out; unsigned char* ws; int ph_lo, ph_hi; };

__device__ __forceinline__ int w1_src_col(int r) {
    if (r < 4096) return r;
    if (r < 5120) return 6160 + (r - 4096);
    if (r < 6144) return 7184 + (r - 5120);
    if (r < 8192) return 8208 + (r - 6144);
    if (r < 12288) { const int t = (r - 8192) >> 8, j = (r - 8192) & 255; return j < 128 ? 4096 + 128 * t + j : 12304 + 128 * t + (j - 128); }
    { const int t = (r - 12288) >> 8, j = (r - 12288) & 255; return j < 128 ? 10256 + 128 * t + j : 14352 + 128 * t + (j - 128); }
}
__device__ __forceinline__ void p0_tile_load(const float* W, int ldw, int k0, int srcA, int srcB, f32x4 (&v)[8], int wave, int lane) {
    const float* p = W + (size_t)(k0 + 8 * wave) * ldw + (lane < 32 ? srcA : srcB) + 4 * (lane & 31);
#pragma unroll
    for (int i = 0; i < 8; ++i) v[i] = __builtin_nontemporal_load((const f32x4*)(p + (size_t)i * ldw));
}
__device__ __forceinline__ void p0_tile_store(LAS unsigned char* lds, const f32x4 (&v)[8], bf16* WT, int K, int k0, int n0, int wave, int lane) {
    constexpr int RS = 528;
#pragma unroll
    for (int i = 0; i < 8; ++i) { u32x2 w; w.x = cvtpk(v[i][0], v[i][1]); w.y = cvtpk(v[i][2], v[i][3]); *(LAS u32x2*)(lds + (8 * wave + i) * RS + 8 * lane) = w; }
    __syncthreads();
    const int g = lane >> 4, i16 = lane & 15, q = i16 >> 2, p = lane & 3;
#pragma unroll
    for (int it = 0; it < 4; ++it) { const int nb = it >> 1, kg = 4 * (it & 1) + g;
        LAS unsigned char* ad = lds + (8 * kg + q) * RS + (32 * wave + 16 * nb + 4 * p) * 2;
        const s16x4 lo = vtr(ad), hi = vtr(ad + 4 * RS);
        const bf16x8 pc = __builtin_shufflevector(lo, hi, 0, 1, 2, 3, 4, 5, 6, 7);
        *(bf16x8*)(WT + (size_t)(n0 + 32 * wave + 16 * nb + i16) * K + k0 + 8 * kg) = pc; }
    __syncthreads();
}
template <int N> __device__ __forceinline__ void rs_step(float (&v)[64], int lane) {
    const bool up = (lane & (N / 2)) != 0;
#pragma unroll
    for (int i = 0; i < N / 2; ++i) { const float a0 = v[i], b0 = v[i + N / 2]; const float send = up ? a0 : b0, keep = up ? b0 : a0; v[i] = keep + __shfl_xor(send, N / 2); }
}
__device__ __forceinline__ void sincos_f64(double a, float& c, float& s) {
    const double n = __builtin_rint(a * 0.63661977236758134308);
    double r = __builtin_fma(-n, 1.57079632673412561417e+00, a); r = __builtin_fma(-n, 6.07710050650619224932e-11, r);
    const double r2 = r * r;
    double sp = -1.0 / 1307674368000.0; sp = sp * r2 + 1.0 / 6227020800.0; sp = sp * r2 - 1.0 / 39916800.0; sp = sp * r2 + 1.0 / 362880.0; sp = sp * r2 - 1.0 / 5040.0; sp = sp * r2 + 1.0 / 120.0; sp = sp * r2 - 1.0 / 6.0; sp = sp * r2 + 1.0;
    const double sr = sp * r;
    double cp = 1.0 / 20922789888000.0; cp = cp * r2 - 1.0 / 87178291200.0; cp = cp * r2 + 1.0 / 479001600.0; cp = cp * r2 - 1.0 / 3628800.0; cp = cp * r2 + 1.0 / 40320.0; cp = cp * r2 - 1.0 / 720.0; cp = cp * r2 + 1.0 / 24.0; cp = cp * r2 - 0.5; cp = cp * r2 + 1.0;
    const int q = ((int)n) & 3;
    const double cc = (q == 0) ? cp : (q == 1) ? -sr : (q == 2) ? -cp : sr;
    const double ss = (q == 0) ? sr : (q == 1) ? cp : (q == 2) ? -sr : -cp;
    c = (float)cc; s = (float)ss;
}
__device__ __forceinline__ float inv_freq(int i) {
    const float t[64] = {1.000000000e+00f, 8.639885187e-01f, 7.464760542e-01f, 6.449466944e-01f, 5.572264791e-01f, 4.814372659e-01f, 4.159561992e-01f, 3.593813777e-01f, 3.105013072e-01f, 2.682695687e-01f, 2.317818254e-01f, 2.002568096e-01f, 1.730195731e-01f, 1.494869143e-01f, 1.291549653e-01f, 1.115884036e-01f, 9.641107917e-02f, 8.329805732e-02f, 7.196855545e-02f, 6.218000501e-02f, 5.372281000e-02f, 4.641588405e-02f, 4.010278732e-02f, 3.464834765e-02f, 2.993576974e-02f, 2.586415969e-02f, 2.234633639e-02f, 1.930697635e-02f, 1.668100618e-02f, 1.441219542e-02f, 1.245197095e-02f, 1.075835899e-02f, 9.295095690e-03f, 8.030855097e-03f, 6.938566454e-03f, 5.994840525e-03f, 5.179473199e-03f, 4.475005437e-03f, 3.866353072e-03f, 3.340484342e-03f, 2.886139555e-03f, 2.493591513e-03f, 2.154434333e-03f, 1.861406374e-03f, 1.608233666e-03f, 1.389495214e-03f, 1.200507861e-03f, 1.037224894e-03f, 8.961504791e-04f, 7.742635789e-04f, 6.689548027e-04f, 5.779692437e-04f, 4.993587499e-04f, 4.314401885e-04f, 3.727593285e-04f, 3.220597573e-04f, 2.782559313e-04f, 2.404098923e-04f, 2.077113895e-04f, 1.794602285e-04f, 1.550515735e-04f, 1.339627634e-04f, 1.157422957e-04f, 9.999999747e-05f};
    return t[i];
}
__device__ __forceinline__ float logsigmoid(float g) { return fminf(g, 0.f) - __logf(1.0f + __expf(-fabsf(g))); }

__device__ __forceinline__ void phase0(const Args& a, LAS unsigned char* lds, int vcu, int G, int tid) {
    const int lane = tid & 63, wave = __builtin_amdgcn_readfirstlane(tid >> 6);
    unsigned char* ws = a.ws;
    for (int repA = 0; repA < (REP_PHASE == 9 ? 2 : 1); ++repA)
    { float* RT = (float*)(ws + WS_RT);
      for (int e = vcu * NT + tid; e < 2052 * 64; e += G * NT) { const int ridx = e >> 6, i = e & 63; const int pos = ridx < 2048 ? ridx : 16384 + (ridx - 2048);
          const float ang = __fmul_rn((float)pos, inv_freq(i)); float c, s; sincos_f64((double)ang, c, s); *(f32x2*)(RT + (size_t)e * 2) = (f32x2){c, s}; } }
    { const float* w_in = a.in[4]; const float* w_lr = a.in[5]; const float* b_lr = a.in[6];
      bf16* XB = (bf16*)(ws + WS_XB); float* BC = (float*)(ws + WS_BC);
      LAS float* T = (LAS float*)lds;
      LAS float* lrs = (LAS float*)(lds + 131072);
      bool staged = false;
      for (int repB = 0; repB < (REP_PHASE == 7 ? 2 : 1); ++repB)
      for (int it = vcu; it < MP / 32 + MS / 4; it += G) {
          if (!staged) {
              for (int idx = tid; idx < 8192; idx += NT) { const int k = idx >> 2, c = idx & 3; const f32x4 v = *(const f32x4*)(w_in + (size_t)k * NIN + 6144 + 4 * c);
                  const int pos = ((k & 255) >> 2) + 64 * (k & 3) + (k & ~255); *(LAS f32x4*)(T + (size_t)(c * 2048 + pos) * 4) = v; }
              staged = true; __syncthreads(); }
          const bool prm = it < MP / 32; const int row0 = prm ? it * 32 : MP + (it - MP / 32) * 4, nrows = prm ? 32 : 4, clen = prm ? CLP : CLS;
          if (4 * wave < nrows) {
            const float* xr[4];
#pragma unroll
            for (int rr = 0; rr < 4; ++rr) { const int r = row0 + 4 * wave + rr; xr[rr] = r < MP ? a.in[0] + (size_t)r * DM : a.in[1] + (size_t)(r - MP) * DM; }
            float acc[64];
#pragma unroll
            for (int i = 0; i < 64; ++i) acc[i] = 0.f;
#define P0_ROWPASS(ps) do { f32x4 xv[2][8]; \
                _Pragma("unroll") for (int r2 = 0; r2 < 2; ++r2) _Pragma("unroll") for (int j = 0; j < 8; ++j) xv[r2][j] = __builtin_nontemporal_load((const f32x4*)(xr[2 * (ps) + r2] + 4 * lane + 256 * j)); \
                _Pragma("unroll") for (int r2 = 0; r2 < 2; ++r2) _Pragma("unroll") for (int j = 0; j < 8; ++j) { u32x2 w; w.x = cvtpk(xv[r2][j][0], xv[r2][j][1]); w.y = cvtpk(xv[r2][j][2], xv[r2][j][3]); \
                    *(u32x2*)(XB + (size_t)(row0 + 4 * wave + 2 * (ps) + r2) * DM + 4 * lane + 256 * j) = w; } \
                _Pragma("unroll") for (int j = 0; j < 8; ++j) _Pragma("unroll") for (int i = 0; i < 4; ++i) _Pragma("unroll") for (int c = 0; c < 4; ++c) { \
                    const f32x4 w = *(const LAS f32x4*)(T + (size_t)(c * 2048 + lane + 64 * i + 256 * j) * 4); \
                    _Pragma("unroll") for (int r2 = 0; r2 < 2; ++r2) _Pragma("unroll") for (int e = 0; e < 4; ++e) acc[(2 * (ps) + r2) * 16 + 4 * c + e] += xv[r2][j][i] * w[e]; } \
                asm volatile("" ::: "memory"); } while (0)
            P0_ROWPASS(0); P0_ROWPASS(1);
#undef P0_ROWPASS
            rs_step<64>(acc, lane); rs_step<32>(acc, lane); rs_step<16>(acc, lane); rs_step<8>(acc, lane); rs_step<4>(acc, lane); rs_step<2>(acc, lane);
            lrs[64 * wave + lane] = acc[0];
          }
          __syncthreads();
#pragma unroll 1
          for (int cc = 0; cc < 2; ++cc) { const int c = tid + 512 * cc; float w[16];
#pragma unroll
              for (int j = 0; j < 16; ++j) w[j] = w_lr[j * 1024 + c];
              const float b = b_lr[c]; float run = 0.f;
#pragma unroll 4
              for (int t = 0; t < nrows; ++t) { if ((t & (clen - 1)) == 0) run = 0.f; float g = b;
#pragma unroll
                  for (int q = 0; q < 4; ++q) { const f32x4 l = *(const LAS f32x4*)(lrs + t * 16 + 4 * q); g += l[0] * w[4 * q] + l[1] * w[4 * q + 1] + l[2] * w[4 * q + 2] + l[3] * w[4 * q + 3]; }
                  run += logsigmoid(g) * 0.0625f; BC[(size_t)(row0 + t) * 1024 + c] = run; } }
          __syncthreads();
      } }
    __syncthreads();
    { bf16* W1T = (bf16*)(ws + WS_W1T); bf16* W2T = (bf16*)(ws + WS_W2T);
      constexpr int T1 = (DM / 64) * (N1 / 256), T2 = (DM / 64) * (DM / 256);
      f32x4 va[8], vb[8];
#define P0_TILE_ARGS(t, W, ldw, k0, sA, sB, WT, n0) const float* W; int ldw, k0, sA, sB, n0; bf16* WT; \
      if ((t) < T1) { const int kb = (t) / (N1 / 256), nb = (t) % (N1 / 256); W = a.in[4]; ldw = NIN; k0 = 64 * kb; n0 = 256 * nb; sA = w1_src_col(n0); sB = w1_src_col(n0 + 128); WT = W1T; } \
      else { const int r_ = (t) - T1, kb = r_ / (DM / 256), nb = r_ % (DM / 256); W = a.in[10]; ldw = DM; k0 = 64 * kb; n0 = 256 * nb; sA = n0; sB = n0 + 128; WT = W2T; }
      for (int repC = 0; repC < (REP_PHASE == 8 ? 2 : 1); ++repC) {
      int t = vcu;
      if (t < T1 + T2) { P0_TILE_ARGS(t, W, ldw, k0, sA, sB, WT, n0) p0_tile_load(W, ldw, k0, sA, sB, va, wave, lane); (void)WT; (void)n0; }
      for (; t < T1 + T2; t += 2 * G) {
          const int t1 = t + G, t2 = t + 2 * G;
          if (t1 < T1 + T2) { P0_TILE_ARGS(t1, W, ldw, k0, sA, sB, WT, n0) p0_tile_load(W, ldw, k0, sA, sB, vb, wave, lane); (void)WT; (void)n0; }
          { P0_TILE_ARGS(t, W, ldw, k0, sA, sB, WT, n0) (void)W; (void)ldw; (void)sA; (void)sB; p0_tile_store(lds, va, WT, DM, k0, n0, wave, lane); }
          if (t2 < T1 + T2) { P0_TILE_ARGS(t2, W, ldw, k0, sA, sB, WT, n0) p0_tile_load(W, ldw, k0, sA, sB, va, wave, lane); (void)WT; (void)n0; }
          if (t1 < T1 + T2) { P0_TILE_ARGS(t1, W, ldw, k0, sA, sB, WT, n0) (void)W; (void)ldw; (void)sA; (void)sB; p0_tile_store(lds, vb, WT, DM, k0, n0, wave, lane); }
      }
      }
#undef P0_TILE_ARGS
    }
}

__device__ __forceinline__ void phase2(const Args& a, int vcu, int G, int tid) {
    const int lane = tid & 63, wave = __builtin_amdgcn_readfirstlane(tid >> 6), r = lane & 31, hh = lane >> 5;
    unsigned char* ws = a.ws; const int gw = vcu * NWAVES + wave, NGW = G * NWAVES;
    for (int it = gw; it < 1024 + 2048; it += NGW) {
        const bf16 *Qp, *Kp; bf16* Pp; int nst;
        if (it < 1024) { const int b = it >> 8, h = (it >> 6) & 3, ch = it & 63; const size_t off = (size_t)(b * 2048 + ch * 32) * 1024 + h * 256;
            Qp = (const bf16*)(ws + WS_QAT) + off; Kp = (const bf16*)(ws + WS_KAT) + off; Pp = (bf16*)(ws + WS_PG) + (size_t)it * 1024; nst = 16; }
        else { const int i2 = it - 1024, b = i2 >> 9, h = (i2 >> 6) & 7, ch = i2 & 63; const size_t off = (size_t)(b * 2048 + ch * 32) * 1024 + h * 128;
            Qp = (const bf16*)(ws + WS_QBT) + off; Kp = (const bf16*)(ws + WS_KBT) + off; Pp = (bf16*)(ws + WS_PR) + (size_t)i2 * 1024; nst = 8; }
        f32x16 d;
#pragma unroll
        for (int i = 0; i < 16; ++i) d[i] = 0.f;
        const bf16* qa = Qp + (size_t)r * 1024 + 8 * hh; const bf16* ka = Kp + (size_t)r * 1024 + 8 * hh;
        for (int s = 0; s < nst; ++s) { const bf16x8 af = *(const bf16x8*)(ka + 16 * s), bq = *(const bf16x8*)(qa + 16 * s); d = MFMA32(af, bq, d); }
#pragma unroll
        for (int g = 0; g < 4; ++g) { const int s0 = 8 * g + 4 * hh; float v[4];
#pragma unroll
            for (int j = 0; j < 4; ++j) v[j] = (s0 + j <= r) ? d[4 * g + j] : 0.f;
            u32x2 w; w.x = cvtpk(v[0], v[1]); w.y = cvtpk(v[2], v[3]); *(u32x2*)(Pp + r * 32 + s0) = w; }
    }
}

template <int KD, int VD>
__device__ __forceinline__ void scan_item(LAS unsigned char* lds, const bf16* Qg, const bf16* Kg, const bf16* Vg, const bf16* Pg, const float* BCg, float dscal, bf16* Og, float* Sg, int s_stride, int tid) {
    constexpr int QS = KD * 2 + 8, KS = KD * 2 + 64, VS = VD * 2 + 64, PS = 80;
    constexpr int OFF_Q = 0, OFF_K = OFF_Q + 32 * QS, OFF_V = OFF_K + 32 * KS, OFF_P = OFF_V + 32 * VS, OFF_D = OFF_P + 32 * PS, OFF_X = OFF_D + KD * 4;
    constexpr int QPT = (32 * KD / 8) / NT, VPT = (32 * VD / 8) / NT, QPR = KD / 8, VPR = VD / 8;
    constexpr int NVQ = VD / 32, NKH = 8 / NVQ;
    static_assert(QPT >= 1 && VPT >= 1 && OFF_X + 16384 <= 131072, "scan LDS map");
    const int lane = tid & 63, wave = __builtin_amdgcn_readfirstlane(tid >> 6), r = lane & 31, hh = lane >> 5;
    const int vq = wave % NVQ, kh = wave / NVQ;
        const int q4 = (lane & 15) >> 2, p4 = lane & 3, blk = (lane >> 4) & 1;
    const int vaddr = OFF_V + (8 * hh + q4) * VS + (32 * vq + 16 * blk + 4 * p4) * 2;
    const int kaddr = OFF_K + (8 * hh + q4) * KS + (128 * kh + 16 * blk + 4 * p4) * 2;
    const int qaddr = OFF_Q + r * QS + (128 * kh + 4 * hh) * 2;
    const int paddr = OFF_P + r * PS + 16 * hh;
    const int daddr = OFF_D + (128 * kh + 4 * hh) * 4;
    LAS float* xb = (LAS float*)(lds + OFF_X);
    f32x16 S[4];
#pragma unroll
    for (int kt = 0; kt < 4; ++kt)
#pragma unroll
        for (int i = 0; i < 16; ++i) S[kt][i] = 0.f;
    u32x4 rq[QPT], rk[QPT], rv[VPT], rm;
#define SCAN_LOAD(c) do { const int r0_ = (c) * 32; \
        _Pragma("unroll") for (int i_ = 0; i_ < QPT; ++i_) { const int p_ = tid + NT * i_, row_ = p_ / QPR, pc_ = p_ % QPR; \
            rq[i_] = *(const u32x4*)(Qg + (size_t)(r0_ + row_) * 1024 + pc_ * 8); rk[i_] = *(const u32x4*)(Kg + (size_t)(r0_ + row_) * 1024 + pc_ * 8); } \
        _Pragma("unroll") for (int i_ = 0; i_ < VPT; ++i_) { const int p_ = tid + NT * i_, row_ = p_ / VPR, pc_ = p_ % VPR; rv[i_] = *(const u32x4*)(Vg + (size_t)(r0_ + row_) * 2048 + pc_ * 8); } \
        if (tid < 128) rm = *(const u32x4*)(Pg + (size_t)(c) * 1024 + tid * 8); \
        else if (BCg != nullptr && tid < 128 + KD / 4) rm = *(const u32x4*)(BCg + (size_t)(r0_ + 31) * 1024 + (tid - 128) * 4); } while (0)
    SCAN_LOAD(0);
#pragma unroll 1
    for (int c = 0; c < NCH; ++c) {
#pragma unroll
        for (int i = 0; i < QPT; ++i) { const int p = tid + NT * i, row = p / QPR, pc = p % QPR;
            *(LAS u32x2*)(lds + OFF_Q + row * QS + pc * 16) = (u32x2){rq[i].x, rq[i].y}; *(LAS u32x2*)(lds + OFF_Q + row * QS + pc * 16 + 8) = (u32x2){rq[i].z, rq[i].w};
            *(LAS u32x4*)(lds + OFF_K + row * KS + pc * 16) = rk[i]; }
#pragma unroll
        for (int i = 0; i < VPT; ++i) { const int p = tid + NT * i, row = p / VPR, pc = p % VPR; *(LAS u32x4*)(lds + OFF_V + row * VS + pc * 16) = rv[i]; }
        if (tid < 128) *(LAS u32x4*)(lds + OFF_P + (tid >> 2) * PS + (tid & 3) * 16) = rm;
        else if (BCg != nullptr && tid < 128 + KD / 4) { f32x4 e;
#pragma unroll
            for (int j = 0; j < 4; ++j) { const unsigned u = rm[j]; e[j] = __expf(__uint_as_float(u)); }
            *(LAS f32x4*)(lds + OFF_D + (tid - 128) * 16) = e; }
        __syncthreads();
        if (c + 1 < NCH) SCAN_LOAD(c + 1);
        bf16x8 vf[2];
#pragma unroll
        for (int s = 0; s < 2; ++s) { const s16x4 lo = vtr(lds + vaddr + (16 * s) * VS), hi = vtr(lds + vaddr + (16 * s + 4) * VS); vf[s] = __builtin_shufflevector(lo, hi, 0, 1, 2, 3, 4, 5, 6, 7); }
        f32x16 O;
#pragma unroll
        for (int i = 0; i < 16; ++i) O[i] = 0.f;
#pragma unroll
        for (int kt = 0; kt < 4; ++kt)
#pragma unroll
            for (int s = 0; s < 2; ++s) {
                const s16x4 alo = *(const LAS s16x4*)(lds + qaddr + (32 * kt + 16 * s) * 2), ahi = *(const LAS s16x4*)(lds + qaddr + (32 * kt + 16 * s + 8) * 2);
                const bf16x8 A = __builtin_shufflevector(alo, ahi, 0, 1, 2, 3, 4, 5, 6, 7);
                u32x4 pb; pb.x = cvtpk(S[kt][8 * s + 0], S[kt][8 * s + 1]); pb.y = cvtpk(S[kt][8 * s + 2], S[kt][8 * s + 3]); pb.z = cvtpk(S[kt][8 * s + 4], S[kt][8 * s + 5]); pb.w = cvtpk(S[kt][8 * s + 6], S[kt][8 * s + 7]);
                O = MFMA32(A, __builtin_bit_cast(bf16x8, pb), O); }
        if (kh == 0) {
#pragma unroll
            for (int s = 0; s < 2; ++s) { const bf16x8 A = *(const LAS bf16x8*)(lds + paddr + 32 * s); O = MFMA32(A, vf[s], O); } }
        if (NKH == 2 && kh == 1) {
#pragma unroll
            for (int i = 0; i < 16; ++i) xb[(vq * 16 + i) * 64 + lane] = O[i]; }
#pragma unroll
        for (int kt = 0; kt < 4; ++kt)
#pragma unroll
            for (int g = 0; g < 4; ++g) { f32x4 dv;
                if (BCg != nullptr) dv = *(const LAS f32x4*)(lds + daddr + (32 * kt + 8 * g) * 4); else dv = (f32x4){dscal, dscal, dscal, dscal};
#pragma unroll
                for (int j = 0; j < 4; ++j) S[kt][4 * g + j] *= dv[j]; }
#pragma unroll
        for (int kt = 0; kt < 4; ++kt)
#pragma unroll
            for (int s = 0; s < 2; ++s) { const s16x4 lo = vtr(lds + kaddr + kt * 64 + (16 * s) * KS), hi = vtr(lds + kaddr + kt * 64 + (16 * s + 4) * KS);
                S[kt] = MFMA32(__builtin_shufflevector(lo, hi, 0, 1, 2, 3, 4, 5, 6, 7), vf[s], S[kt]); }
        __syncthreads();
        if (kh == 0) {
            if (NKH == 2) {
#pragma unroll
                for (int i = 0; i < 16; ++i) O[i] += xb[(vq * 16 + i) * 64 + lane]; }
            bf16* op = Og + (size_t)(c * 32) * 2048 + 32 * vq + r;
#pragma unroll
            for (int i = 0; i < 16; ++i) op[(size_t)crow(i, hh) * 2048] = (bf16)(cvtpk(O[i], 0.f) & 0xffffu);
        }
    }
#undef SCAN_LOAD
#pragma unroll
    for (int kt = 0; kt < 4; ++kt)
#pragma unroll
        for (int i = 0; i < 16; ++i) Sg[(size_t)(128 * kh + 32 * kt + crow(i, hh)) * s_stride + 32 * vq + r] = S[kt][i];
    __syncthreads();
}

template <int KD, int VW, int VDF>
__device__ __forceinline__ void stream_item(LAS unsigned char* lds, const float* S0, float* S1, const bf16* Qp, const bf16* Ktp, const bf16* Khp, const float* BCl, float dscal,
                                            const bf16* Vp, bf16* Op, int tid) {
    constexpr int CG = VW / 4, RG = NT / CG, RPT = KD / RG;
    static_assert(RPT == 16, "stream item geometry");
    LAS float* sc = (LAS float*)lds;
    LAS float* wred = (LAS float*)(lds + 12288);
    LAS float* pp = (LAS float*)(lds + 12288 + 512);
    LAS float* red = (LAS float*)(lds + 16384);
    const int lane = tid & 63, wave = __builtin_amdgcn_readfirstlane(tid >> 6);
    if (tid < KD) { const int k = tid; float q[4], kt[4], kh[4];
#pragma unroll
        for (int t = 0; t < 4; ++t) { q[t] = bf2f(Qp[(size_t)t * 1024 + k]); kt[t] = bf2f(Ktp[(size_t)t * 1024 + k]); kh[t] = bf2f(Khp[(size_t)t * 1024 + k]); }
        const float d = BCl != nullptr ? __expf(BCl[k]) : dscal;
        *(LAS f32x4*)(sc + k * 12) = (f32x4){q[0], q[1], q[2], q[3]}; *(LAS f32x4*)(sc + k * 12 + 4) = (f32x4){kh[0], kh[1], kh[2], kh[3]}; sc[k * 12 + 8] = d;
#pragma unroll
        for (int t = 0; t < 4; ++t)
#pragma unroll
            for (int s = 0; s < 4; ++s) { const float v = wave_sum(q[t] * kt[s]); if (lane == 0) wred[wave * 16 + t * 4 + s] = v; }
    }
    __syncthreads();
    if (tid < 16) { float v = 0.f;
#pragma unroll
        for (int w = 0; w < KD / 64; ++w) v += wred[w * 16 + tid];
        pp[tid] = ((tid & 3) <= (tid >> 2)) ? v : 0.f; }
    const int rg = tid / CG, cg = tid % CG;
    f32x4 vv[4];
#pragma unroll
    for (int s = 0; s < 4; ++s) { const u32x2 w = *(const u32x2*)(Vp + (size_t)s * 2048 + 4 * cg); vv[s] = (f32x4){bflo(w.x), bfhi(w.x), bflo(w.y), bfhi(w.y)}; }
    f32x4 O[4];
#pragma unroll
    for (int t = 0; t < 4; ++t) O[t] = (f32x4){0.f, 0.f, 0.f, 0.f};
#pragma unroll
    for (int half = 0; half < 2; ++half) {
        f32x4 sv[8];
#pragma unroll
        for (int i = 0; i < 8; ++i) { const int k = rg + RG * (8 * half + i); sv[i] = __builtin_nontemporal_load((const f32x4*)(S0 + (size_t)k * VDF + 4 * cg)); }
#pragma unroll
        for (int i = 0; i < 8; ++i) { const int k = rg + RG * (8 * half + i);
            const f32x4 q = *(const LAS f32x4*)(sc + k * 12), kh = *(const LAS f32x4*)(sc + k * 12 + 4); const float d = sc[k * 12 + 8];
            f32x4 sn = sv[i] * d;
#pragma unroll
            for (int s = 0; s < 4; ++s) sn += vv[s] * kh[s];
            __builtin_nontemporal_store(sn, (f32x4*)(S1 + (size_t)k * VDF + 4 * cg));
#pragma unroll
            for (int t = 0; t < 4; ++t) O[t] += sv[i] * q[t]; }
    }
#pragma unroll
    for (int t = 0; t < 4; ++t) *(LAS f32x4*)(red + (size_t)(rg * 4 + t) * VW + 4 * cg) = O[t];
    __syncthreads();
    for (int idx = tid; idx < 4 * VW; idx += NT) { const int t = idx / VW, v = idx % VW; float o = 0.f;
#pragma unroll
        for (int g = 0; g < RG; ++g) o += red[(size_t)(g * 4 + t) * VW + v];
#pragma unroll
        for (int s = 0; s < 4; ++s) o += pp[t * 4 + s] * bf2f(Vp[(size_t)s * 2048 + v]);
        Op[(size_t)t * 2048 + v] = (bf16)(cvtpk(o, 0.f) & 0xffffu); }
    __syncthreads();
}

__device__ __forceinline__ void phase3(const Args& a, LAS unsigned char* lds, gu32* ctl, int tid) {
    unsigned char* ws = a.ws; const int bx = blockIdx.x;
    const bf16* QAT = (const bf16*)(ws + WS_QAT); const bf16* KAT = (const bf16*)(ws + WS_KAT); const bf16* KAH = (const bf16*)(ws + WS_KAH); const bf16* VA = (const bf16*)(ws + WS_VA);
    const bf16* QBT = (const bf16*)(ws + WS_QBT); const bf16* KBT = (const bf16*)(ws + WS_KBT); const bf16* KBH = (const bf16*)(ws + WS_KBH); const bf16* VB = (const bf16*)(ws + WS_VB);
    const float* BC = (const float*)(ws + WS_BC); bf16* OA = (bf16*)(ws + WS_OA); bf16* OB = (bf16*)(ws + WS_OB);
    if (bx < 64) { const int b = bx >> 4, h = (bx >> 2) & 3, vs = bx & 3; const size_t ro = (size_t)b * 2048;
        scan_item<256, 128>(lds, QAT + ro * 1024 + h * 256, KAH + ro * 1024 + h * 256, VA + ro * 2048 + h * 512 + vs * 128, (const bf16*)(ws + WS_PG) + (size_t)((b * 4 + h) * NCH) * 1024,
                            BC + ro * 1024 + h * 256, 0.f, OA + ro * 2048 + h * 512 + vs * 128, a.out + OUT_SGP + (size_t)((b * 4 + h) * 256) * 512 + vs * 128, 512, tid);
    } else if (bx < 96) { const int i = bx - 64, b = i >> 3, h = i & 7; const size_t ro = (size_t)b * 2048;
        scan_item<128, 256>(lds, QBT + ro * 1024 + h * 128, KBH + ro * 1024 + h * 128, VB + ro * 2048 + h * 256, (const bf16*)(ws + WS_PR) + (size_t)((b * 8 + h) * NCH) * 1024,
                            nullptr, __builtin_amdgcn_exp2f((float)CLP * lg2gamma(h)), OB + ro * 2048 + h * 256, a.out + OUT_SRP + (size_t)((b * 8 + h) * 128) * 256, 256, tid);
    }
    volatile LAS int* qslot = (volatile LAS int*)(lds + MISC_OFF + 64);
    for (;;) {
        if (tid == 0) *qslot = (int)__hip_atomic_fetch_add((unsigned*)(ctl + CW_QUEUE), 1u, __ATOMIC_RELAXED, __HIP_MEMORY_SCOPE_AGENT);
        __syncthreads();
        const int it = *qslot;
        __syncthreads();
        if (it >= 2048 + 1024) break;
        if (it < 2048) { const int b = it >> 4, h = (it >> 2) & 3, vs = it & 3; const size_t r0 = MP + (size_t)b * 4; const size_t so = (size_t)((b * 4 + h) * 256) * 512 + vs * 128;
            stream_item<256, 128, 512>(lds, a.in[2] + so, a.out + OUT_SGS + so, QAT + r0 * 1024 + h * 256, KAT + r0 * 1024 + h * 256, KAH + r0 * 1024 + h * 256, BC + (r0 + 3) * 1024 + h * 256, 0.f,
                                       VA + r0 * 2048 + h * 512 + vs * 128, OA + r0 * 2048 + h * 512 + vs * 128, tid);
        } else { const int i = it - 2048, b = i >> 3, h = i & 7; const size_t r0 = MP + (size_t)b * 4; const size_t so = (size_t)((b * 8 + h) * 128) * 256;
            stream_item<128, 256, 256>(lds, a.in[3] + so, a.out + OUT_SRS + so, QBT + r0 * 1024 + h * 128, KBT + r0 * 1024 + h * 128, KBH + r0 * 1024 + h * 128, nullptr,
                                       __builtin_amdgcn_exp2f((float)CLS * lg2gamma(h)), VB + r0 * 2048 + h * 256, OB + r0 * 2048 + h * 256, tid);
        }
    }
}

__device__ __forceinline__ void phase4(const Args& a, LAS unsigned char* lds, int vcu, int G, int tid) {
    const int lane = tid & 63, wave = __builtin_amdgcn_readfirstlane(tid >> 6); unsigned char* ws = a.ws; const int gw = vcu * NWAVES + wave, NGW = G * NWAVES;
    const bf16* OA = (const bf16*)(ws + WS_OA); const bf16* OB = (const bf16*)(ws + WS_OB); const bf16* PA = (const bf16*)(ws + WS_PA); const bf16* PB = (const bf16*)(ws + WS_PB); bf16* MG = (bf16*)(ws + WS_MG);
    LAS float* wg = (LAS float*)lds; LAS float* wr = wg + 512; LAS float* wb = wr + 2048;
    for (int i = tid; i < 512; i += NT) wg[i] = a.in[7][i];
    for (int i = tid; i < 2048; i += NT) { wr[i] = a.in[8][i]; wb[i] = a.in[9][i]; }
    __syncthreads();
    u32x4 ca[2], cb[2], cpa[2], cpb[2], na[2], nb[2], npa[2], npb[2];
#define P4_LOAD(w_, xa, xb, xpa, xpb) do { const size_t o_ = (size_t)((w_) >> 1) * 2048 + 1024 * ((w_) & 1) + 16 * lane; _Pragma("unroll") for (int q_ = 0; q_ < 2; ++q_) { \
        xa[q_] = *(const u32x4*)(OA + o_ + 8 * q_); xb[q_] = *(const u32x4*)(OB + o_ + 8 * q_); xpa[q_] = *(const u32x4*)(PA + o_ + 8 * q_); xpb[q_] = *(const u32x4*)(PB + o_ + 8 * q_); } } while (0)
    int w = gw;
    if (w < 2 * MT) P4_LOAD(w, ca, cb, cpa, cpb);
    for (; w < 2 * MT; w += NGW) {
        const int wn = w + NGW;
        if (wn < 2 * MT) P4_LOAD(wn, na, nb, npa, npb);
        const int c0 = 1024 * (w & 1) + 16 * lane;
        float ssa = 0.f, sb = 0.f;
#pragma unroll
        for (int q = 0; q < 2; ++q)
#pragma unroll
            for (int e = 0; e < 4; ++e) { const unsigned ua = ca[q][e], ub = cb[q][e]; const float a0 = bflo(ua), a1 = bfhi(ua); ssa += a0 * a0 + a1 * a1; sb += bflo(ub) + bfhi(ub); }
#pragma unroll
        for (int o = 1; o < 32; o <<= 1) ssa += __shfl_xor(ssa, o);
#pragma unroll
        for (int o = 1; o < 16; o <<= 1) sb += __shfl_xor(sb, o);
        const float rms = 1.0f / sqrtf(ssa * (1.f / 512.f) + HN_EPS), mean = sb * (1.f / 256.f);
        float qb = 0.f;
#pragma unroll
        for (int q = 0; q < 2; ++q)
#pragma unroll
            for (int e = 0; e < 4; ++e) { const unsigned ub = cb[q][e]; const float b0 = bflo(ub) - mean, b1 = bfhi(ub) - mean; qb += b0 * b0 + b1 * b1; }
#pragma unroll
        for (int o = 1; o < 16; o <<= 1) qb += __shfl_xor(qb, o);
        const float rstd = 1.0f / sqrtf(qb * (1.f / 256.f) + HN_EPS);
#pragma unroll
        for (int q = 0; q < 2; ++q) { float o[8];
#pragma unroll
            for (int h2 = 0; h2 < 2; ++h2) { const int i0 = 8 * q + 4 * h2; const f32x4 g4 = *(const LAS f32x4*)(wg + ((c0 + i0) & 511)), r4 = *(const LAS f32x4*)(wr + c0 + i0), b4 = *(const LAS f32x4*)(wb + c0 + i0);
#pragma unroll
                for (int e = 0; e < 4; ++e) { const unsigned upa = cpa[q][2 * h2 + (e >> 1)], upb = cpb[q][2 * h2 + (e >> 1)], ua = ca[q][2 * h2 + (e >> 1)], ub = cb[q][2 * h2 + (e >> 1)];
                    const float pa = (e & 1) ? bfhi(upa) : bflo(upa), pb = (e & 1) ? bfhi(upb) : bflo(upb), xa = (e & 1) ? bfhi(ua) : bflo(ua), xb = ((e & 1) ? bfhi(ub) : bflo(ub)) - mean;
                    o[4 * h2 + e] = pa * (xa * rms * g4[e]) + pb * (xb * rstd * r4[e] + b4[e]); } }
            u32x4 wv; wv.x = cvtpk(o[0], o[1]); wv.y = cvtpk(o[2], o[3]); wv.z = cvtpk(o[4], o[5]); wv.w = cvtpk(o[6], o[7]);
            *(u32x4*)(MG + (size_t)(w >> 1) * 2048 + c0 + 8 * q) = wv; }
#pragma unroll
        for (int q = 0; q < 2; ++q) { ca[q] = na[q]; cb[q] = nb[q]; cpa[q] = npa[q]; cpb[q] = npb[q]; }
    }
#undef P4_LOAD
    __syncthreads();
}

__device__ __forceinline__ void phase6(const Args& a, int vcu, int G, int tid) {
    const int lane = tid & 63, wave = __builtin_amdgcn_readfirstlane(tid >> 6); const int gw = vcu * NWAVES + wave, NGW = G * NWAVES;
    const float* lw = a.in[11]; const float* lb = a.in[12];
    f32x4 v[8], nx[8];
    int m = gw;
    if (m < MT) {
#pragma unroll
        for (int j = 0; j < 8; ++j) v[j] = *((const f32x4*)(a.out + (size_t)m * DM) + lane + 64 * j); }
    for (; m < MT; m += NGW) { const int mn = m + NGW;
        if (mn < MT) {
#pragma unroll
            for (int j = 0; j < 8; ++j) nx[j] = *((const f32x4*)(a.out + (size_t)mn * DM) + lane + 64 * j); }
        float s = 0.f;
#pragma unroll
        for (int j = 0; j < 8; ++j) s += (v[j][0] + v[j][1]) + (v[j][2] + v[j][3]);
        const float mean = wave_sum(s) * (1.f / DM); float s2 = 0.f;
#pragma unroll
        for (int j = 0; j < 8; ++j) { v[j] = v[j] - mean; s2 += (v[j][0] * v[j][0] + v[j][1] * v[j][1]) + (v[j][2] * v[j][2] + v[j][3] * v[j][3]); }
        const float rstd = 1.0f / sqrtf(wave_sum(s2) * (1.f / DM) + LN_EPS);
        f32x4* xr = (f32x4*)(a.out + (size_t)m * DM) + lane;
#pragma unroll
        for (int j = 0; j < 8; ++j) { const f32x4 w = *((const f32x4*)lw + lane + 64 * j), bb = *((const f32x4*)lb + lane + 64 * j); xr[64 * j] = v[j] * rstd * w + bb; }
#pragma unroll
        for (int j = 0; j < 8; ++j) v[j] = nx[j];
    }
}

__global__ void __launch_bounds__(NT, 2) mega_fwd(Args a) {
    extern __shared__ __attribute__((aligned(16))) unsigned char lds_raw[];
    LAS unsigned char* lds = (LAS unsigned char*)lds_raw;
    const int tid = threadIdx.x;
    const int G = gridDim.x; const int bx = blockIdx.x; const int vcu = (G % 8 == 0) ? (bx % 8) * (G / 8) + bx / 8 : bx;
    volatile LAS unsigned* MISC = (volatile LAS unsigned*)(lds + MISC_OFF);
    if (tid < 64) MISC[tid] = 0u;
    __syncthreads();
    gu32* ctl = (gu32*)(a.ws + WS_CTL);
    const int lo = a.ph_lo, hi = a.ph_hi;
    XcdBarrier bar; bar.bar = (unsigned*)(ctl + CW_BAR); bar.x = 0; bar.st = nullptr;
    if (hi - lo > 1) bar = xcd_barrier_post((unsigned*)(ctl + CW_BAR), MISC + 8);
#ifndef REP_PHASE
#define REP_PHASE -1
#endif
#define IN(k) (lo <= (k) && (k) < hi)
#define NREP(k) ((k) == REP_PHASE ? 2 : 1)
#define SEAM(k) do { if (IN(k) && IN((k) + 1)) xcd_barrier(bar); } while (0)
    unsigned char* ws = a.ws;
    if (IN(0)) { for (int rep = 0; rep < NREP(0); ++rep) { phase0(a, lds, vcu, G, tid); __syncthreads(); } }
    SEAM(0);
    if (IN(1)) {
        pg8::Gemm g{(const pg8::bf16_t*)(ws + WS_XB), (const pg8::bf16_t*)(ws + WS_W1T), MT, N1, DM}; pg8::StaticOrder S; S.init(MT, N1, G, bx);
        EpiG1 E{(bf16*)(ws + WS_QAT), (bf16*)(ws + WS_KAT), (bf16*)(ws + WS_KAH), (bf16*)(ws + WS_VA), (bf16*)(ws + WS_QBT), (bf16*)(ws + WS_KBT), (bf16*)(ws + WS_KBH), (bf16*)(ws + WS_VB),
                (bf16*)(ws + WS_PA), (bf16*)(ws + WS_PB), (const float*)(ws + WS_BC), (const float*)(ws + WS_RT)};
        for (int rep = 0; rep < NREP(1); ++rep) pg8::gemm_phase<EpiG1, pg8::StaticOrder, true, true>(lds, g, S, E);
    }
    SEAM(1);
    if (IN(2)) { for (int rep = 0; rep < NREP(2); ++rep) phase2(a, vcu, G, tid); }
    SEAM(2);
    if (IN(3)) { phase3(a, lds, ctl, tid); if (REP_PHASE == 3) phase3(a, lds, ctl + 64, tid); }
    SEAM(3);
    if (IN(4)) { for (int rep = 0; rep < NREP(4); ++rep) phase4(a, lds, vcu, G, tid); }
    SEAM(4);
    if (IN(5)) {
        pg8::Gemm g{(const pg8::bf16_t*)(ws + WS_MG), (const pg8::bf16_t*)(ws + WS_W2T), MT, DM, DM}; pg8::StaticOrder S; S.init(MT, DM, G, bx);
        EpiG2 E{a.in[0], a.in[1], a.out + OUT_Y};
        for (int rep = 0; rep < NREP(5); ++rep) pg8::gemm_phase<EpiG2, pg8::StaticOrder, true, true>(lds, g, S, E);
    }
    SEAM(5);
    if (IN(6)) { phase6(a, vcu, G, tid); }
#undef IN
#undef SEAM
}

extern "C" void kernel_launch(void* const* d_in, const int* in_sizes, int n_in, void* d_out, int out_size, void* d_ws, size_t ws_size, hipStream_t stream) {
    static int grid = 0;
    if (grid == 0) {
        if (n_in != 13 || in_sizes[0] != MP * DM || in_sizes[1] != MS * DM || (size_t)out_size != OUT_TOTAL || ws_size < WS_END) {
            fprintf(stderr, "kernel_launch: unexpected shapes (n_in %d, in0 %d, in1 %d, out %d, ws %zu); nothing launched\n", n_in, n_in > 0 ? in_sizes[0] : -1, n_in > 1 ? in_sizes[1] : -1, out_size, ws_size); grid = -1; return; }
        int dev = 0, cus = 0, per_cu = 0;
        if (hipGetDevice(&dev) != hipSuccess || hipDeviceGetAttribute(&cus, hipDeviceAttributeMultiprocessorCount, dev) != hipSuccess) { fprintf(stderr, "kernel_launch: device query failed\n"); grid = -1; return; }
        if (hipFuncSetAttribute((const void*)mega_fwd, hipFuncAttributeMaxDynamicSharedMemorySize, LDS_BYTES) != hipSuccess) { fprintf(stderr, "kernel_launch: hipFuncSetAttribute failed\n"); grid = -1; return; }
        if (hipOccupancyMaxActiveBlocksPerMultiprocessor(&per_cu, (const void*)mega_fwd, NT, LDS_BYTES) != hipSuccess || per_cu < 1) { fprintf(stderr, "kernel_launch: occupancy query says %d workgroups per CU\n", per_cu); (void)hipGetLastError(); grid = -1; return; }
        grid = cus;
        if (grid < 96 || grid % 8 != 0) { fprintf(stderr, "kernel_launch: %d CUs unsupported\n", grid); grid = -1; return; }
    }
    if (grid < 0) return;
    if (hipMemsetAsync((char*)d_ws + WS_CTL, 0, CTL_ZERO_BYTES, stream) != hipSuccess) { fprintf(stderr, "kernel_launch: memset failed\n"); return; }
    Args a{};
    for (int i = 0; i < 13; ++i) a.in[i] = (const float*)d_in[i];
    a.out = (float*)d_out; a.ws = (unsigned char*)d_ws;
    if (MK_N_LAUNCHES == 1) { a.ph_lo = 0; a.ph_hi = N_PHASES; hipLaunchKernelGGL(mega_fwd, dim3(grid), dim3(NT), LDS_BYTES, stream, a); }
    else { for (int p = 0; p < N_PHASES; ++p) { a.ph_lo = p; a.ph_hi = p + 1; hipLaunchKernelGGL(mega_fwd, dim3(grid), dim3(NT), LDS_BYTES, stream, a); } }
    const hipError_t le = hipPeekAtLastError();
    if (le != hipSuccess) fprintf(stderr, "kernel_launch: launch failed: %s\n", hipGetErrorName(le));
}
```
